# Optimizing an MI355X kernel written in HIP

```python
import jax, jax.numpy as jnp
from jax import lax
import numpy as np

D_MODEL = 1024
BATCH = 2
SEQ = 8192
DEPTH = 2

GRID_W = 64
CTX_LEN = 256
HEAD_DIM = 64
NA_HEADS = 4
NA_WIN_R = 8
NA_WIN_C = 16
NA_QCB = 16
NA_BAND = 32
FNET_GROUPS = 4
FNET_GROUP_DIM = 64
SWA_HEADS = 4
SWA_KV_HEADS = 2
SWA_WINDOW = 128
SWA_BLOCK = 128
HGRN_HEADS = 4
HGRN_DK = 64
HGRN_DV = 64
HGRN_CHUNK = 64
ROPE_THETA = 10000.0
EPS = 1e-6
W_A = NA_HEADS * HEAD_DIM
W_B = FNET_GROUPS * FNET_GROUP_DIM
W_C = SWA_HEADS * HEAD_DIM
W_C_KV = SWA_KV_HEADS * HEAD_DIM
W_DK = HGRN_HEADS * HGRN_DK
W_DV = HGRN_HEADS * HGRN_DV
D_MIX = W_A + W_B + W_C + W_DV
IN_SPLITS = (W_A, W_A, W_A, W_B, W_C, W_C_KV, W_C_KV, W_DK, W_DK, W_DK, W_DV, W_DV)
D_IN = sum(IN_SPLITS)
D_FF = -(-8 * D_MODEL // (3 * 256)) * 256

kernel_name = "hybrid_natten_fnet_swa_hgrn2_dit"

F32 = jnp.float32


def rms_norm(x, g):
    xf = x.astype(F32)
    y = xf * lax.rsqrt(jnp.mean(xf * xf, axis=-1, keepdims=True) + EPS)
    return (y * g.astype(F32)).astype(x.dtype)


def modulate(h, shift, scale):
    return h * (1 + scale) + shift


def split_in(y):
    out, start = [], 0
    for w in IN_SPLITS:
        out.append(y[..., start:start + w])
        start += w
    return out


def heads(t, n):
    b, l, _ = t.shape
    return t.reshape(b, l, n, -1).transpose(0, 2, 1, 3)


def merge(t):
    b, h, l, d = t.shape
    return t.transpose(0, 2, 1, 3).reshape(b, l, h * d)


def rope_1d(x, pos):
    half = x.shape[-1] // 2
    freqs = ROPE_THETA ** (-jnp.arange(half, dtype=F32) / half)
    ang = jnp.asarray(pos, F32)[:, None] * freqs
    cos, sin = jnp.cos(ang).astype(x.dtype), jnp.sin(ang).astype(x.dtype)
    x1, x2 = x[..., :half], x[..., half:]
    return jnp.concatenate([x1 * cos - x2 * sin, x1 * sin + x2 * cos], axis=-1)


def axial_rope(x, rows, cols):
    half = x.shape[-1] // 2
    return jnp.concatenate([rope_1d(x[..., :half], rows), rope_1d(x[..., half:], cols)], axis=-1)


def dense_attention(q, k, v, sink=None):
    b, hq, l, d = q.shape
    g = k.shape[1]
    qg = q.reshape(b, g, hq // g, l, d)
    s = jnp.einsum('bgrqd,bgkd->bgrqk', qg, k).astype(F32) * HEAD_DIM ** -0.5
    if sink is not None:
        s_sink = jnp.broadcast_to(sink.astype(F32).reshape(1, g, hq // g, 1, 1), s.shape[:-1] + (1,))
        s = jnp.concatenate([s, s_sink], axis=-1)
    p = jax.nn.softmax(s, axis=-1)[..., :l].astype(v.dtype)
    return jnp.einsum('bgrqk,bgkd->bgrqd', p, v).reshape(b, hq, l, d)


def neighbourhood_attention(q, k, v, kc, vc, rpb):
    b, h, n, d = q.shape
    rows = n // GRID_W
    kr = min(NA_WIN_R, rows)
    ncb = GRID_W // NA_QCB
    r = np.arange(rows)
    row_idx = np.clip(r - kr // 2, 0, rows - kr)[:, None] + np.arange(kr)
    qcol = np.arange(GRID_W).reshape(ncb, NA_QCB)
    cs = np.clip(qcol - NA_WIN_C // 2, 0, GRID_W - NA_WIN_C)
    band = np.clip(np.arange(ncb) * NA_QCB - NA_WIN_C // 2, 0, GRID_W - NA_BAND)[:, None] + np.arange(NA_BAND)
    col_ok = (band[:, None, :] >= cs[:, :, None]) & (band[:, None, :] < cs[:, :, None] + NA_WIN_C)
    dr = row_idx - r[:, None] + NA_WIN_R - 1
    dc = np.clip(band[:, None, :] - qcol[:, :, None], -(NA_WIN_C - 1), NA_WIN_C - 1) + NA_WIN_C - 1
    bias = rpb[:, dr[:, None, None, :, None], dc[None, :, :, None, :]].astype(F32)
    bias = jnp.where(col_ok[None, None, :, :, None, :], bias, -jnp.inf)
    qg = q.reshape(b, h, rows, ncb, NA_QCB, d)
    gi_r, gi_c = row_idx[:, :, None, None], band[None, None, :, :]
    kg = k.reshape(b, h, rows, GRID_W, d)[:, :, gi_r, gi_c]
    vg = v.reshape(b, h, rows, GRID_W, d)[:, :, gi_r, gi_c]
    scale = HEAD_DIM ** -0.5
    s_nb = jnp.einsum('bhrcqd,bhrwckd->bhrcqwk', qg, kg).astype(F32) * scale + bias
    s_nb = s_nb.reshape(b, h, rows, ncb, NA_QCB, kr * NA_BAND)
    s_ctx = jnp.einsum('bhrcqd,bhjd->bhrcqj', qg, kc).astype(F32) * scale
    p = jax.nn.softmax(jnp.concatenate([s_nb, s_ctx], axis=-1), axis=-1)
    p_nb = p[..., :kr * NA_BAND].reshape(b, h, rows, ncb, NA_QCB, kr, NA_BAND).astype(v.dtype)
    p_ctx = p[..., kr * NA_BAND:].astype(v.dtype)
    o = jnp.einsum('bhrcqwk,bhrwckd->bhrcqd', p_nb, vg) + jnp.einsum('bhrcqj,bhjd->bhrcqd', p_ctx, vc)
    return o.reshape(b, h, n, d)


def fourier_mix(u):
    b, l, _ = u.shape
    z = jnp.fft.fft2(u.astype(F32).reshape(b, l, FNET_GROUPS, FNET_GROUP_DIM), axes=(1, 3), norm='ortho')
    return jnp.real(z).reshape(b, l, W_B).astype(u.dtype)


def sliding_window_gqa(q, k, v, kc, vc, sink):
    b, hq, n, d = q.shape
    g = k.shape[1]
    rep = hq // g
    blk = SWA_BLOCK
    nb = n // blk
    lc = kc.shape[2]
    qb = q.reshape(b, g, rep, nb, blk, d)

    def banded(t):
        tp = jnp.pad(t, ((0, 0), (0, 0), (blk, blk), (0, 0))).reshape(b, g, nb + 2, blk, d)
        return jnp.concatenate([tp[:, :, :-2], tp[:, :, 1:-1], tp[:, :, 2:]], axis=3)

    kb, vb = banded(k), banded(v)
    i = np.arange(blk)
    m = np.arange(3 * blk)
    rel = m[None, :] - blk - i[:, None]
    s_pos = np.arange(nb)[:, None, None] * blk - blk + m[None, None, :]
    ok = (np.abs(rel)[None] <= SWA_WINDOW) & (s_pos >= 0) & (s_pos < n)
    scale = HEAD_DIM ** -0.5
    s_loc = jnp.einsum('bgrnqd,bgnkd->bgrnqk', qb, kb).astype(F32) * scale
    s_loc = jnp.where(ok, s_loc, -jnp.inf)
    s_ctx = jnp.einsum('bgrnqd,bgjd->bgrnqj', qb, kc).astype(F32) * scale
    s_sink = jnp.broadcast_to(sink.astype(F32).reshape(1, g, rep, 1, 1, 1), s_loc.shape[:-1] + (1,))
    p = jax.nn.softmax(jnp.concatenate([s_loc, s_ctx, s_sink], axis=-1), axis=-1)
    p_loc = p[..., :3 * blk].astype(v.dtype)
    p_ctx = p[..., 3 * blk:3 * blk + lc].astype(v.dtype)
    o = jnp.einsum('bgrnqk,bgnkd->bgrnqd', p_loc, vb) + jnp.einsum('bgrnqj,bgjd->bgrnqd', p_ctx, vc)
    return o.reshape(b, hq, n, d)


def hgrn2_gates(fz, lb):
    lb = lb.reshape(HGRN_HEADS, 1, HGRN_DK)
    logf = jnp.logaddexp(jnp.log(lb), jnp.log1p(-lb) + jax.nn.log_sigmoid(fz.astype(F32)))
    return logf, -jnp.expm1(logf)


def chunk_gated_scan(q, k, v, logf, s0):
    b, h, l, dk = q.shape
    dv = v.shape[-1]
    nc = l // HGRN_CHUNK
    causal = np.tril(np.ones((HGRN_CHUNK, HGRN_CHUNK), dtype=bool))

    def to_chunks(t):
        return jnp.moveaxis(t.reshape(b, h, nc, HGRN_CHUNK, t.shape[-1]), 2, 0)

    def step(state, inp):
        qc, kc, vc, gc = inp
        cum = jnp.cumsum(gc, axis=2)
        decay = jnp.exp(jnp.where(causal[:, :, None], cum[:, :, :, None, :] - cum[:, :, None, :, :], -jnp.inf))
        att = jnp.einsum('bhtk,bhsk,bhtsk->bhts', qc, kc, decay)
        o = jnp.einsum('bhts,bhsv->bhtv', att, vc) + jnp.einsum('bhtk,bhkv->bhtv', qc * jnp.exp(cum), state)
        last = cum[:, :, -1]
        state = jnp.exp(last)[..., None] * state + jnp.einsum('bhsk,bhsv->bhkv', kc * jnp.exp(last[:, :, None, :] - cum), vc)
        return state, o

    s_fin, o = lax.scan(step, s0, (to_chunks(q), to_chunks(k), to_chunks(v), to_chunks(logf)))
    return jnp.moveaxis(o, 0, 2).reshape(b, h, l, dv), s_fin


def hgrn2_bidir(q, fz_f, fz_b, v, lb_f, lb_b, s0_f, s0_b):
    dt = v.dtype
    q32, v32 = q.astype(F32), v.astype(F32)
    logf_f, k_f = hgrn2_gates(fz_f, lb_f)
    logf_b, k_b = hgrn2_gates(fz_b, lb_b)
    o_f, s_f = chunk_gated_scan(q32, k_f, v32, logf_f, s0_f)
    rev = lambda t: jnp.flip(t, axis=2)
    o_b, s_b = chunk_gated_scan(rev(q32), rev(k_b), rev(v32), rev(logf_b), s0_b)
    return (o_f + rev(o_b)).astype(dt), s_f, s_b


def hgrn_out(o, g, gain):
    om = merge(o)
    b, l, _ = om.shape
    on = rms_norm(om.reshape(b, l, HGRN_HEADS, HGRN_DV), gain.reshape(HGRN_HEADS, HGRN_DV)).reshape(b, l, W_DV)
    return on * jax.nn.silu(g)


def swiglu(h, w_in, w_out):
    a, gt = jnp.split(h @ w_in, 2, axis=-1)
    return (jax.nn.silu(a) * gt) @ w_out


def setup_inputs(seed: int = 0) -> dict:
    key = jax.random.key(seed)
    ks = jax.random.split(key, 20)
    nrm = lambda k, shape, s: jax.random.normal(k, shape, F32) * s
    return {
        'x': nrm(ks[0], (BATCH, SEQ, D_MODEL), 1.0),
        'c': nrm(ks[1], (BATCH, D_MODEL), 1.0),
        'ctx': nrm(ks[2], (BATCH, CTX_LEN, D_MODEL), 1.0),
        'c_ctx': nrm(ks[3], (D_MODEL,), 1.0),
        'w_ada': nrm(ks[4], (DEPTH, D_MODEL, 6 * D_MODEL), 0.5 * D_MODEL ** -0.5),
        'b_ada': nrm(ks[5], (DEPTH, 6 * D_MODEL), 0.02),
        'g_pre_mix': 1.0 + nrm(ks[6], (DEPTH, D_MODEL), 0.1),
        'g_post_mix': 1.0 + nrm(ks[7], (DEPTH, D_MODEL), 0.1),
        'g_pre_ffn': 1.0 + nrm(ks[8], (DEPTH, D_MODEL), 0.1),
        'g_post_ffn': 1.0 + nrm(ks[9], (DEPTH, D_MODEL), 0.1),
        'w_in': nrm(ks[10], (DEPTH, D_MODEL, D_IN), D_MODEL ** -0.5),
        'w_out': nrm(ks[11], (DEPTH, D_MIX, D_MODEL), D_MIX ** -0.5),
        'na_rpb': nrm(ks[12], (DEPTH, NA_HEADS, 2 * NA_WIN_R - 1, 2 * NA_WIN_C - 1), 0.2),
        'w_fnet': nrm(ks[13], (DEPTH, W_B, W_B), W_B ** -0.5),
        'swa_sink': nrm(ks[14], (DEPTH, SWA_HEADS), 1.0),
        'hgrn_lb_logits': nrm(ks[15], (2, DEPTH, W_DK), 1.0),
        'hgrn_norm_g': 1.0 + nrm(ks[16], (DEPTH, W_DV), 0.1),
        'w_ffn_in': nrm(ks[17], (DEPTH, D_MODEL, 2 * D_FF), D_MODEL ** -0.5),
        'w_ffn_out': nrm(ks[18], (DEPTH, D_FF, D_MODEL), D_FF ** -0.5),
    }


def reference(x, c, ctx, c_ctx, w_ada, b_ada, g_pre_mix, g_post_mix, g_pre_ffn, g_post_ffn, w_in, w_out,
              na_rpb, w_fnet, swa_sink, hgrn_lb_logits, hgrn_norm_g, w_ffn_in, w_ffn_out):
    b, n, _ = x.shape
    pos = np.arange(n)
    rows_pos, cols_pos = pos // GRID_W, pos % GRID_W
    lb_all = jnp.cumsum(jax.nn.softmax(hgrn_lb_logits.astype(F32), axis=1), axis=1)
    lb_all = lb_all - lb_all[:, :1]
    s_zero = jnp.zeros((b, HGRN_HEADS, HGRN_DK, HGRN_DV), F32)
    h_ctx = ctx
    for l in range(DEPTH):
        sh1, sc1, gt1, sh2, sc2, gt2 = jnp.split((jax.nn.silu(c) @ w_ada[l] + b_ada[l])[:, None, :], 6, axis=-1)
        csh1, csc1, cgt1, csh2, csc2, cgt2 = jnp.split((jax.nn.silu(c_ctx) @ w_ada[l] + b_ada[l])[None, None, :], 6, axis=-1)
        u = modulate(rms_norm(x, g_pre_mix[l]), sh1, sc1) @ w_in[l]
        uc = modulate(rms_norm(h_ctx, g_pre_mix[l]), csh1, csc1) @ w_in[l]
        qa, ka, va, ub, qs, ks, vs, qd, fdf, fdb, iv, gd = split_in(u)
        qa_c, ka_c, va_c, ub_c, qs_c, ks_c, vs_c, qd_c, fdf_c, fdb_c, iv_c, gd_c = split_in(uc)
        ka_c, va_c = heads(ka_c, NA_HEADS), heads(va_c, NA_HEADS)
        ks_c, vs_c = heads(ks_c, SWA_KV_HEADS), heads(vs_c, SWA_KV_HEADS)
        od_c, s_f, s_b = hgrn2_bidir(jax.nn.silu(heads(qd_c, HGRN_HEADS)), heads(fdf_c, HGRN_HEADS),
                                     heads(fdb_c, HGRN_HEADS), heads(iv_c, HGRN_HEADS),
                                     lb_all[0, l], lb_all[1, l], s_zero, s_zero)
        o_a = neighbourhood_attention(heads(qa, NA_HEADS), heads(ka, NA_HEADS), heads(va, NA_HEADS), ka_c, va_c, na_rpb[l])
        o_b = fourier_mix(ub) @ w_fnet[l]
        o_c = sliding_window_gqa(axial_rope(heads(qs, SWA_HEADS), rows_pos, cols_pos),
                                 axial_rope(heads(ks, SWA_KV_HEADS), rows_pos, cols_pos),
                                 heads(vs, SWA_KV_HEADS), ks_c, vs_c, swa_sink[l])
        od, _, _ = hgrn2_bidir(jax.nn.silu(heads(qd, HGRN_HEADS)), heads(fdf, HGRN_HEADS), heads(fdb, HGRN_HEADS),
                               heads(iv, HGRN_HEADS), lb_all[0, l], lb_all[1, l], s_f, s_b)
        o_d = hgrn_out(od, gd, hgrn_norm_g[l])
        mix = jnp.concatenate([merge(o_a), o_b, merge(o_c), o_d], axis=-1) @ w_out[l]
        x = x + gt1 * rms_norm(mix, g_post_mix[l])
        ffn = swiglu(modulate(rms_norm(x, g_pre_ffn[l]), sh2, sc2), w_ffn_in[l], w_ffn_out[l])
        x = x + gt2 * rms_norm(ffn, g_post_ffn[l])
        if l < DEPTH - 1:
            o_a_c = dense_attention(heads(qa_c, NA_HEADS), ka_c, va_c)
            o_b_c = fourier_mix(ub_c) @ w_fnet[l]
            o_c_c = dense_attention(heads(qs_c, SWA_HEADS), ks_c, vs_c, swa_sink[l])
            o_d_c = hgrn_out(od_c, gd_c, hgrn_norm_g[l])
            mix_c = jnp.concatenate([merge(o_a_c), o_b_c, merge(o_c_c), o_d_c], axis=-1) @ w_out[l]
            h_ctx = h_ctx + cgt1 * rms_norm(mix_c, g_post_mix[l])
            ffn_c = swiglu(modulate(rms_norm(h_ctx, g_pre_ffn[l]), csh2, csc2), w_ffn_in[l], w_ffn_out[l])
            h_ctx = h_ctx + cgt2 * rms_norm(ffn_c, g_post_ffn[l])
    return x
```

```cpp
#include <hip/hip_runtime.h>
#include <hip/hip_cooperative_groups.h>
#include <cstdio>
#include <cstdint>
namespace cg = cooperative_groups;

#ifndef MK_SINGLE
#define MK_SINGLE 0
#ifndef DBG_ZERO
#define DBG_ZERO 0
#endif
#ifndef DBG_NPH
#define DBG_NPH 0
#endif
#ifndef DBG_ROWSEL
#define DBG_ROWSEL 0
#endif
#ifndef DBG_NAIVE
#define DBG_NAIVE 0
#endif
#ifndef DBG_DUP
#define DBG_DUP 0
#endif
#ifndef DBG_DUP2
#define DBG_DUP2 0
#endif
#ifndef DBG_DUPK
#define DBG_DUPK 0
#endif
#ifndef HG_BAR
#define HG_BAR 3
#endif
#ifndef DBG_SUB
#define DBG_SUB 15
#endif
#endif

__device__ __forceinline__ int opaque_tid(int w0) { int t; asm volatile("v_mbcnt_lo_u32_b32 %0, -1, 0\n\tv_mbcnt_hi_u32_b32 %0, -1, %0" : "=v"(t)); return w0 * 64 + t; }

namespace pg8 {
#define PG8_LAS __attribute__((address_space(3)))
typedef unsigned short bf16_t;
typedef short bf16x8 __attribute__((ext_vector_type(8)));
typedef float f32x4 __attribute__((ext_vector_type(4)));
typedef unsigned u32x4 __attribute__((ext_vector_type(4)));
constexpr int BM = 256, BK = 64, HALF = 128, HTB = HALF * BK * 2  , STAGE_BYTES = 8 * HTB, NXCD = 8, WGM = 8;

__host__ __device__ __forceinline__ int lds_byte(int r, int c) { const int st = (r >> 4) * 2 + (c >> 5), rr = r & 15, cc = c & 31, ob = rr * 64 + cc * 2; return st * 1024 + (ob ^ (((ob >> 9) & 1) << 5)); }
__host__ __device__ __forceinline__ void stage_rc(int b, int& R, int& C) { const int st = b / 1024, sb = b % 1024, swz = sb ^ (((sb >> 9) & 1) << 5); R = (st >> 1) * 16 + swz / 64; C = (st & 1) * 32 + (swz % 64) / 2; }
__host__ __device__ __forceinline__ int perm32(int rho) { const int n = rho >> 4, i = rho & 15; return 8 * (i >> 2) + 4 * n + (i & 3); }

struct Unit { int pm, pn, ks; };
struct Gemm { const bf16_t* A; const bf16_t* Bt; int M, N, K, ldk; };

struct StaticOrder {
    int nM, nN, nwg, G, c;
    __host__ __device__ void init(int M, int N, int G_, int c_) { nM = M / BM; nN = N / BM; nwg = nM * nN; G = G_; c = c_; }
    __host__ __device__ bool next(int i, Unit& u) const {
        const long L = (long)i * G + c; if (L >= nwg) return false;
        int wgid = (int)L; { const int q = nwg / NXCD, r = nwg % NXCD, xcd = wgid % NXCD, off = wgid / NXCD; wgid = (xcd < r ? xcd * (q + 1) : r * (q + 1) + (xcd - r) * q) + off; }
        const int nig = WGM * nN, gid = wgid / nig, fm = gid * WGM, gsz = (nM - fm) < WGM ? (nM - fm) : WGM;
        u.pm = fm + ((wgid % nig) % gsz); u.pn = (wgid % nig) / gsz; u.ks = 0; return true;
    }
    __device__ __forceinline__ void a_ready(const Unit&) const {}
    __device__ __forceinline__ void done(const Unit&) const {}
};

__device__ __forceinline__ unsigned cvt_pk_bf16(float lo, float hi) { unsigned r; asm volatile("v_cvt_pk_bf16_f32 %0, %1, %2" : "=v"(r) : "v"(lo), "v"(hi)); return r; }
template <class Epi, class Sched, bool ALIGN_EPI = false, bool SP2 = false>
__device__ __forceinline__ void gemm_phase(PG8_LAS unsigned char* lds, const Gemm g, const Sched& S, const Epi& E, const int W0) {
    const int tid = opaque_tid(W0), wid = __builtin_amdgcn_readfirstlane(tid >> 6), lane = tid & 63, wr = wid >> 2, wc = wid & 3, fr = lane & 15, fq = lane >> 4;
    const int K = g.ldk, nt = g.K / BK;
    const size_t sstep = (size_t)g.K * 2;
    unsigned voffA[2], voffB[2];
#pragma unroll
    for (int i = 0; i < 2; ++i) { int R, C; stage_rc(tid * 16 + i * 8192, R, C); const int Rb = Epi::PERM ? ((R & ~31) + perm32(R & 31)) : R;
        voffA[i] = (unsigned)(R * K + C) * 2u; voffB[i] = (unsigned)(Rb * K + C) * 2u; }
    const size_t kstep = (size_t)(BK * 2);
    const size_t hstep = (size_t)HALF * K * 2;
    const size_t tstep = 2 * hstep;
    const unsigned ldsw = (unsigned)wid * 1024u;
    const int aoff = lds_byte(wr * 64 + fr, fq * 8), boff = lds_byte(wc * 32 + fr, fq * 8);
#define PG8_SA(b, h) (((b) * 2 + (h)) * HTB)
#define PG8_SB(b, h) ((4 + (b) * 2 + (h)) * HTB)
#define PG8_STAGE(bufoff, gbase, voff) do { _Pragma("unroll") for (int _i = 0; _i < 2; ++_i) \
        __builtin_amdgcn_global_load_lds((const unsigned*)((const char*)(gbase) + (voff)[_i]), (PG8_LAS unsigned*)(lds + (bufoff) + ldsw + _i * 8192), 16, 0, 0); } while (0)
#define PG8_LDA(dst, b, h) do { _Pragma("unroll") for (int m = 0; m < 4; ++m) _Pragma("unroll") for (int k = 0; k < 2; ++k) dst[m][k] = *(const PG8_LAS bf16x8*)(lds + PG8_SA(b, h) + aoff + m * 2048 + k * 1024); } while (0)
#define PG8_LDB(dst, b, h) do { _Pragma("unroll") for (int n = 0; n < 2; ++n) _Pragma("unroll") for (int k = 0; k < 2; ++k) dst[n][k] = *(const PG8_LAS bf16x8*)(lds + PG8_SB(b, h) + boff + n * 2048 + k * 1024); } while (0)
#define PG8_MMA(ai, bj, At, Bt) do { __builtin_amdgcn_s_setprio(1); _Pragma("unroll") for (int m = 0; m < 4; ++m) _Pragma("unroll") for (int n = 0; n < 2; ++n) _Pragma("unroll") for (int k = 0; k < 2; ++k) \
        acc[ai][bj][m][n] = __builtin_amdgcn_mfma_f32_16x16x32_bf16(Bt[n][k], At[m][k], acc[ai][bj][m][n], 0, 0, 0); __builtin_amdgcn_s_setprio(0); } while (0)
#define PG8_WAIT_V(n) asm volatile("s_waitcnt vmcnt(" #n ")" ::: "memory")
#define PG8_WAIT_L(n) asm volatile("s_waitcnt lgkmcnt(" #n ")" ::: "memory")
#define PG8_BAR __builtin_amdgcn_s_barrier()
#define PG8_SCHED __builtin_amdgcn_sched_barrier(0)
    Unit cur, nxt; int ui = 0;
    if (!S.next(0, cur)) return;
    f32x4 acc[2][2][4][2];
#pragma unroll
    for (int a = 0; a < 2; ++a)
#pragma unroll
        for (int b = 0; b < 2; ++b)
#pragma unroll
            for (int m = 0; m < 4; ++m)
#pragma unroll
                for (int n = 0; n < 2; ++n) acc[a][b][m][n] = (f32x4){0.f, 0.f, 0.f, 0.f};
    bf16x8 At[4][2], B0[2][2], B1[2][2];
    const char* cA = (const char*)g.A + (size_t)cur.pm * tstep + (size_t)cur.ks * sstep; const char* cB = (const char*)g.Bt + (size_t)cur.pn * tstep + (size_t)cur.ks * sstep;
    S.a_ready(cur);
    if constexpr (SP2) {
        PG8_STAGE(PG8_SB(0, 0), cB, voffB); PG8_STAGE(PG8_SB(0, 1), cB + hstep, voffB); PG8_STAGE(PG8_SA(0, 0), cA, voffA); PG8_STAGE(PG8_SA(0, 1), cA + hstep, voffA);
        if (wr == 1) PG8_BAR;
        PG8_WAIT_V(2); PG8_BAR;
        PG8_STAGE(PG8_SB(1, 0), cB + kstep, voffB); PG8_STAGE(PG8_SA(1, 0), cA + kstep, voffA); PG8_STAGE(PG8_SB(1, 1), cB + hstep + kstep, voffB);
        PG8_WAIT_V(6); PG8_BAR;
    } else {
        PG8_STAGE(PG8_SB(0, 0), cB, voffB); PG8_STAGE(PG8_SA(0, 0), cA, voffA); PG8_STAGE(PG8_SB(0, 1), cB + hstep, voffB); PG8_STAGE(PG8_SA(0, 1), cA + hstep, voffA);
        if (wr == 1) PG8_BAR;
        PG8_WAIT_V(4); PG8_BAR;
        PG8_STAGE(PG8_SB(1, 0), cB + kstep, voffB); PG8_STAGE(PG8_SA(1, 0), cA + kstep, voffA); PG8_STAGE(PG8_SB(1, 1), cB + hstep + kstep, voffB);
        PG8_WAIT_V(6); PG8_BAR;
    }
    for (;;) {
        const bool has_next = S.next(ui + 1, nxt);
        const char* nA = has_next ? (const char*)g.A + (size_t)nxt.pm * tstep + (size_t)nxt.ks * sstep : cA; const char* nB = has_next ? (const char*)g.Bt + (size_t)nxt.pn * tstep + (size_t)nxt.ks * sstep : cB;
        for (int t = 0; t < nt; t += 2) {
            const bool last = (t == nt - 2);
            const char* a1 = cA + (size_t)(t + 1) * kstep;
            const char* a2 = last ? nA : cA + (size_t)(t + 2) * kstep; const char* b2 = last ? nB : cB + (size_t)(t + 2) * kstep;
            const char* a3 = a2 + kstep; const char* b3 = b2 + kstep;
            if (last && has_next) S.a_ready(nxt);
            if constexpr (SP2) {
            PG8_LDB(B0, 0, 0); PG8_LDB(B1, 0, 1); PG8_SCHED; PG8_LDA(At, 0, 0); PG8_STAGE(PG8_SA(1, 1), a1 + hstep, voffA);
            PG8_WAIT_V(8); PG8_WAIT_L(0); PG8_BAR; PG8_MMA(0, 0, At, B0); PG8_MMA(0, 1, At, B1); PG8_BAR; PG8_SCHED;
            PG8_LDA(At, 0, 1); PG8_STAGE(PG8_SB(0, 0), b2, voffB); PG8_STAGE(PG8_SB(0, 1), b2 + hstep, voffB); PG8_STAGE(PG8_SA(0, 0), a2, voffA);
            PG8_WAIT_V(8); PG8_WAIT_L(0); PG8_BAR; PG8_MMA(1, 0, At, B0); PG8_MMA(1, 1, At, B1); PG8_BAR; PG8_SCHED;
            PG8_LDB(B0, 1, 0); PG8_LDB(B1, 1, 1); PG8_SCHED; PG8_LDA(At, 1, 0); PG8_STAGE(PG8_SA(0, 1), a2 + hstep, voffA);
            PG8_WAIT_V(8); PG8_WAIT_L(0); PG8_BAR; PG8_MMA(0, 0, At, B0); PG8_MMA(0, 1, At, B1); PG8_BAR; PG8_SCHED;
            PG8_LDA(At, 1, 1); PG8_STAGE(PG8_SB(1, 0), b3, voffB); PG8_STAGE(PG8_SB(1, 1), b3 + hstep, voffB); PG8_STAGE(PG8_SA(1, 0), a3, voffA);
            PG8_WAIT_V(8); PG8_WAIT_L(0); PG8_BAR; PG8_MMA(1, 0, At, B0); PG8_MMA(1, 1, At, B1); PG8_BAR; PG8_SCHED;
            } else {
            PG8_LDB(B0, 0, 0); PG8_SCHED; PG8_LDA(At, 0, 0); PG8_STAGE(PG8_SA(1, 1), a1 + hstep, voffA);
            PG8_WAIT_L(8); PG8_BAR; PG8_WAIT_L(0); PG8_MMA(0, 0, At, B0); PG8_BAR; PG8_SCHED;
            PG8_LDB(B1, 0, 1); PG8_STAGE(PG8_SB(0, 0), b2, voffB);
            PG8_BAR; PG8_WAIT_L(0); PG8_MMA(0, 1, At, B1); PG8_BAR;
            PG8_LDA(At, 0, 1); PG8_STAGE(PG8_SA(0, 0), a2, voffA);
            PG8_BAR; PG8_WAIT_L(0); PG8_MMA(1, 0, At, B0); PG8_BAR; PG8_SCHED;
            PG8_STAGE(PG8_SB(0, 1), b2 + hstep, voffB);
            PG8_WAIT_V(6); PG8_BAR; PG8_MMA(1, 1, At, B1); PG8_BAR;
            PG8_LDB(B0, 1, 0); PG8_SCHED; PG8_LDA(At, 1, 0); PG8_STAGE(PG8_SA(0, 1), a2 + hstep, voffA);
            PG8_WAIT_L(8); PG8_BAR; PG8_WAIT_L(0); PG8_MMA(0, 0, At, B0); PG8_BAR; PG8_SCHED;
            PG8_LDB(B1, 1, 1); PG8_STAGE(PG8_SB(1, 0), b3, voffB);
            PG8_BAR; PG8_WAIT_L(0); PG8_MMA(0, 1, At, B1); PG8_BAR;
            PG8_LDA(At, 1, 1); PG8_STAGE(PG8_SA(1, 0), a3, voffA);
            PG8_BAR; PG8_WAIT_L(0); PG8_MMA(1, 0, At, B0); PG8_BAR; PG8_SCHED;
            PG8_STAGE(PG8_SB(1, 1), b3 + hstep, voffB);
            PG8_WAIT_V(6); PG8_BAR; PG8_MMA(1, 1, At, B1); PG8_BAR;
            }
        }
        if constexpr (ALIGN_EPI) { if (wr == 0) PG8_BAR; }
        if constexpr (!Epi::AFTER_DRAIN) { E(acc, cur, wr, wc, fr, fq); S.done(cur); }
        if (!has_next) break;
#pragma unroll
        for (int a = 0; a < 2; ++a)
#pragma unroll
            for (int b = 0; b < 2; ++b)
#pragma unroll
                for (int m = 0; m < 4; ++m)
#pragma unroll
                    for (int n = 0; n < 2; ++n) acc[a][b][m][n] = (f32x4){0.f, 0.f, 0.f, 0.f};
        cur = nxt; cA = nA; cB = nB; ++ui;
        if constexpr (ALIGN_EPI) { if (wr == 1) PG8_BAR; }
    }
    PG8_WAIT_V(0);
    if constexpr (!ALIGN_EPI) { if (wr == 0) PG8_BAR; }
    PG8_BAR;
    if constexpr (Epi::AFTER_DRAIN) { E.fused(acc, cur, wr, wc, fr, fq, lds, wid, lane); S.done(cur); }
#undef PG8_SA
#undef PG8_SB
#undef PG8_STAGE
#undef PG8_LDA
#undef PG8_LDB
#undef PG8_MMA
#undef PG8_WAIT_V
#undef PG8_WAIT_L
#undef PG8_BAR
#undef PG8_SCHED
}
}

namespace pg8 {
struct SplitOrder {
    int nN, S, nwg, G, c;
    __host__ __device__ void init(int M, int N, int S_, int G_, int c_) { nN = N / BM; S = S_; nwg = (M / BM) * nN * S; G = G_; c = c_; }
    __host__ __device__ bool next(int i, Unit& u) const { const long L = (long)i * G + c; if (L >= nwg) return false; const int l = (int)L; u.ks = l % S; u.pn = (l / S) % nN; u.pm = l / (S * nN); return true; }
    __device__ __forceinline__ void a_ready(const Unit&) const {}
    __device__ __forceinline__ void done(const Unit&) const {}
};
}
#define LAS __attribute__((address_space(3)))
typedef unsigned short bf16_t;
typedef short bf16x8 __attribute__((ext_vector_type(8)));
typedef float f32x4 __attribute__((ext_vector_type(4)));
typedef unsigned u32x4 __attribute__((ext_vector_type(4)));
typedef unsigned u32x2 __attribute__((ext_vector_type(2)));

constexpr int NBATCH = 2, NSEQ = 8192, DM = 1024, NCTX = 256, DEPTH = 2;
constexpr int MLAT = NBATCH * NSEQ;
constexpr int MALL = MLAT + NBATCH * NCTX;
constexpr int DIN = 2816, DFF = 2816, KOUT = 1280;
constexpr float EPS = 1e-6f;
constexpr int C_QA = 0, C_KA = 256, C_VA = 512, C_UB = 768, C_QS = 1024, C_KS = 1280, C_VS = 1408, C_QD = 1536, C_FF = 1792, C_FB = 2048, C_IV = 2304, C_GD = 2560;
constexpr int O_A = 0, O_C = 256, O_D = 512, O_Z = 768;
constexpr int NCHUNK = 132;

constexpr size_t SZ_WIN = (size_t)DIN * DM * 2, SZ_WOUT = (size_t)DM * KOUT * 2, SZ_WFI = (size_t)2 * DFF * DM * 2, SZ_WFO = (size_t)DM * DFF * 2;
constexpr size_t SZ_WL = SZ_WIN + SZ_WOUT + SZ_WFI + SZ_WFO;
constexpr size_t WS_W = 0;
constexpr size_t WS_A = WS_W + 2 * SZ_WL;
constexpr size_t WS_MIX = WS_A + (size_t)MALL * DM * 2;
constexpr size_t WS_BIG = WS_MIX + (size_t)MALL * KOUT * 2;
constexpr size_t WS_R2 = WS_BIG + (size_t)MALL * DIN * 2;
constexpr size_t WS_MISC = WS_R2 + (size_t)MALL * DM * 2;
constexpr size_t WS_ADAP = WS_MISC;
constexpr size_t WS_HCTX = WS_ADAP + (size_t)2 * 8 * 3 * 6144 * 4;
constexpr size_t WS_HD = WS_HCTX + (size_t)512 * 1024 * 4;
constexpr size_t WS_TA = WS_HD + (size_t)16 * NCHUNK * 64 * 4;
constexpr size_t WS_TC = WS_TA + 128 * 64 * 2;
constexpr size_t WS_TCTX = WS_TC + 256 * 256 * 2;
constexpr size_t WS_ROPE = WS_TCTX + 512 * 256 * 2;
constexpr size_t WS_ADAF = WS_ROPE + 128 * 16 * 8;
constexpr size_t WS_CTL = WS_ADAF + (size_t)2 * 3 * 6144 * 4;
constexpr size_t CTL_BYTES = 16384;
constexpr size_t WS_END = WS_CTL + CTL_BYTES;
static_assert(WS_END <= 268435456, "workspace map exceeds 256 MiB");
static_assert((size_t)16 * NCHUNK * 4096 * 4 <= (size_t)MALL * DM * 2, "HGRN states fit R2");

constexpr int LDS_BYTES = 147456;
constexpr int NTHREADS = 512, NWAVES = 8;

struct Params {
    const float* in[19];
    float* out;
    unsigned char* ws;
    int ph_lo, ph_hi;
};

__device__ __forceinline__ const Params* kparams() {
    unsigned long long p = (unsigned long long)__builtin_amdgcn_kernarg_segment_ptr(); asm volatile("" : "+s"(p)); return (const Params*)(const __attribute__((address_space(4))) void*)p; }
__device__ __forceinline__ unsigned f2bf(float f) { unsigned u = __builtin_bit_cast(unsigned, f); return (u + 0x7fffu + ((u >> 16) & 1u)) >> 16; }
typedef float f32x2_t __attribute__((ext_vector_type(2)));
typedef __bf16 bf16x2_t __attribute__((ext_vector_type(2)));
__device__ __forceinline__ unsigned pk2(float lo, float hi) { f32x2_t v = {lo, hi}; bf16x2_t b = __builtin_convertvector(v, bf16x2_t); return __builtin_bit_cast(unsigned, b); }
__device__ __forceinline__ float bf2f(unsigned short h) { return __builtin_bit_cast(float, (unsigned)h << 16); }
__device__ __forceinline__ float bflo(unsigned w) { return __builtin_bit_cast(float, w << 16); }
__device__ __forceinline__ float bfhi(unsigned w) { return __builtin_bit_cast(float, w & 0xffff0000u); }
__device__ __forceinline__ float dpp_f(float v, const int ctrl_unused) { return v; }
__device__ __forceinline__ float wave_sum(float v) {
#define WS_DPP(x, CTRL) __builtin_bit_cast(float, __builtin_amdgcn_update_dpp(0, __builtin_bit_cast(int, (x)), (CTRL), 0xf, 0xf, false))
    v += WS_DPP(v, 0xB1);
    v += WS_DPP(v, 0x4E);
    v += WS_DPP(v, 0x141);
    v += WS_DPP(v, 0x140);
#undef WS_DPP
    const int iv = __builtin_bit_cast(int, v);
    const float r0 = __builtin_bit_cast(float, __builtin_amdgcn_readlane(iv, 0)), r1 = __builtin_bit_cast(float, __builtin_amdgcn_readlane(iv, 16));
    const float r2 = __builtin_bit_cast(float, __builtin_amdgcn_readlane(iv, 32)), r3 = __builtin_bit_cast(float, __builtin_amdgcn_readlane(iv, 48));
    return (r0 + r1) + (r2 + r3);
}
__device__ __forceinline__ float siluf(float a) { return a / (1.f + __expf(-a)); }
__device__ __forceinline__ float sigmoidf_(float a) { return 1.f / (1.f + __expf(-a)); }

struct EpiPlain {
    static constexpr bool PERM = true, AFTER_DRAIN = false;
    bf16_t* O; int ldc; size_t pstride;
    __device__ __forceinline__ void operator()(const f32x4 (&acc)[2][2][4][2], const pg8::Unit& u, int wr, int wc, int fr, int fq) const {
        const int row0 = u.pm * 256 + wr * 64 + fr, col0 = u.pn * 256 + wc * 32 + 8 * fq;
#pragma unroll
        for (int ai = 0; ai < 2; ++ai)
#pragma unroll
            for (int m = 0; m < 4; ++m) { bf16_t* rowp = O + (size_t)u.ks * pstride + (size_t)(row0 + ai * 128 + m * 16) * ldc + col0;
#pragma unroll
                for (int bj = 0; bj < 2; ++bj) { const f32x4 v0 = acc[ai][bj][m][0], v1 = acc[ai][bj][m][1];
                    u32x4 w; w.x = pk2(v0[0], v0[1]); w.y = pk2(v0[2], v0[3]); w.z = pk2(v1[0], v1[1]); w.w = pk2(v1[2], v1[3]);
                    *(u32x4*)(rowp + bj * 128) = w; } }
    }
};
struct EpiSwiGLU {
    static constexpr bool PERM = true, AFTER_DRAIN = false;
    bf16_t* O; int ldc;
    __device__ __forceinline__ void operator()(const f32x4 (&acc)[2][2][4][2], const pg8::Unit& u, int wr, int wc, int fr, int fq) const {
        const int row0 = u.pm * 256 + wr * 64 + fr, col0 = u.pn * 128 + wc * 32 + 8 * fq;
#pragma unroll
        for (int ai = 0; ai < 2; ++ai)
#pragma unroll
            for (int m = 0; m < 4; ++m) { bf16_t* rowp = O + (size_t)(row0 + ai * 128 + m * 16) * ldc + col0;
                float h[8];
#pragma unroll
                for (int n = 0; n < 2; ++n)
#pragma unroll
                    for (int j = 0; j < 4; ++j) { const float a = acc[ai][0][m][n][j], g = acc[ai][1][m][n][j]; h[n * 4 + j] = siluf(a) * g; }
                u32x4 w; w.x = pk2(h[0], h[1]); w.y = pk2(h[2], h[3]); w.z = pk2(h[4], h[5]); w.w = pk2(h[6], h[7]);
                *(u32x4*)rowp = w; }
    }
};
struct EpiU {
    static constexpr bool PERM = false, AFTER_DRAIN = false;
    bf16_t* O; const float* rope;
    __device__ __forceinline__ void operator()(const f32x4 (&acc)[2][2][4][2], const pg8::Unit& u, int wr, int wc, int fr, int fq) const {
        const int row0 = u.pm * 256 + wr * 64 + fr, col0 = u.pn * 256 + wc * 32 + 4 * fq;
        const bool lat = (u.pm < 64);
#pragma unroll
        for (int ai = 0; ai < 2; ++ai)
#pragma unroll
            for (int m = 0; m < 4; ++m) { const int row = row0 + ai * 128 + m * 16; bf16_t* rowp = O + (size_t)row * DIN + col0;
                const int t = row & (NSEQ - 1); const int pos = (wc & 1) ? (t & 63) : (t >> 6);
                f32x4 cs0 = {1.f, 0.f, 1.f, 0.f}, cs1 = {1.f, 0.f, 1.f, 0.f};
                const bool anyrope = lat && (u.pn == 4 || u.pn == 5);
                if (anyrope) { const f32x4* rp = (const f32x4*)(rope + (size_t)(pos * 16 + 4 * fq) * 2); cs0 = rp[0]; cs1 = rp[1]; }
#pragma unroll
                for (int bj = 0; bj < 2; ++bj) { f32x4 v0 = acc[ai][bj][m][0], v1 = acc[ai][bj][m][1];
                    if (anyrope && (u.pn == 4 || bj == 0)) {
                        const float c[4] = {cs0[0], cs0[2], cs1[0], cs1[2]}, s[4] = {cs0[1], cs0[3], cs1[1], cs1[3]};
#pragma unroll
                        for (int j = 0; j < 4; ++j) { const float x1 = v0[j], x2 = v1[j]; v0[j] = x1 * c[j] - x2 * s[j]; v1[j] = x1 * s[j] + x2 * c[j]; }
                    }
                    u32x2 w0, w1; w0.x = pk2(v0[0], v0[1]); w0.y = pk2(v0[2], v0[3]); w1.x = pk2(v1[0], v1[1]); w1.y = pk2(v1[2], v1[3]);
                    *(u32x2*)(rowp + bj * 128) = w0; *(u32x2*)(rowp + bj * 128 + 16) = w1; } }
    }
};

__device__ __forceinline__ void transpose_tile(const float* W, int N, int k0s, int n0s, bf16_t* WT, int ldk, int n0d, int k0d, LAS float* scr, int tid) {
    { const int kk = tid >> 3, c8 = (tid & 7) * 8; const float* src = W + (size_t)(k0s + kk) * N + n0s + c8;
      const f32x4 a = *(const f32x4*)src, b = *(const f32x4*)(src + 4);
#pragma unroll
      for (int e = 0; e < 4; ++e) { scr[(c8 + e) * 65 + kk] = a[e]; scr[(c8 + 4 + e) * 65 + kk] = b[e]; } }
    __syncthreads();
    { const int nn = tid >> 3, k8 = (tid & 7) * 8; const LAS float* s = scr + nn * 65 + k8;
      u32x4 o; o.x = pk2(s[0], s[1]); o.y = pk2(s[2], s[3]); o.z = pk2(s[4], s[5]); o.w = pk2(s[6], s[7]);
      *(u32x4*)(WT + (size_t)(n0d + nn) * ldk + k0d + k8) = o; }
    __syncthreads();
}

__device__ __forceinline__ void phase0(const Params& P_, LAS unsigned char* lds, int W0) {
    const Params& P = *kparams();
    const int tid = opaque_tid(W0), G = gridDim.x, bid = blockIdx.x;
    unsigned char* ws = P.ws;
    LAS float* scr = (LAS float*)lds;
    constexpr int T_IN = 16 * 44, T_OUT = 12 * 16, T_FI = 16 * 88, T_FO = 44 * 16, T_L = T_IN + T_OUT + T_FI + T_FO;
    constexpr int N_TR = 2 * T_L, N_ADA = 2 * 24 * 8, N_M2 = 2 * 4 * 16, N_TAB = 64;
    constexpr int N_ALL = N_TR + N_ADA + N_M2 + N_TAB;
    for (int it = bid; it < N_ALL; it += G) {
        if (it < N_TR) {
            const int l = it / T_L; int r = it % T_L;
            bf16_t* wl = (bf16_t*)(ws + WS_W + (size_t)l * SZ_WL);
            if (r < T_IN) { const int kt = r / 44, nt = r % 44; transpose_tile(P.in[10] + (size_t)l * DM * DIN, DIN, kt * 64, nt * 64, wl, DM, nt * 64, kt * 64, scr, tid); continue; } r -= T_IN;
            if (r < T_OUT) { const int ktd = r / 16, nt = r % 16; const int kts = ktd < 4 ? ktd : ktd + 4;
                transpose_tile(P.in[11] + (size_t)l * DM * DM, DM, kts * 64, nt * 64, (bf16_t*)((unsigned char*)wl + SZ_WIN), KOUT, nt * 64, ktd * 64, scr, tid); continue; } r -= T_OUT;
            if (r < T_FI) { const int kt = r / 88, ntd = r % 88; const int pn = ntd >> 2, bj = (ntd >> 1) & 1, hf = ntd & 1; const int n0s = bj * DFF + pn * 128 + hf * 64;
                transpose_tile(P.in[17] + (size_t)l * DM * 2 * DFF, 2 * DFF, kt * 64, n0s, (bf16_t*)((unsigned char*)wl + SZ_WIN + SZ_WOUT), DM, ntd * 64, kt * 64, scr, tid); continue; } r -= T_FI;
            { const int kt = r / 16, nt = r % 16; transpose_tile(P.in[18] + (size_t)l * DFF * DM, DM, kt * 64, nt * 64, (bf16_t*)((unsigned char*)wl + SZ_WIN + SZ_WOUT + SZ_WFI), DFF, nt * 64, kt * 64, scr, tid); }
            continue;
        }
        int r = it - N_TR;
        if (r < N_ADA) {
            const int l = r / 192, jc = (r % 192) / 8, kc = r % 8;
            LAS float* sv = scr;
            LAS float* red = scr + 384;
            if (tid < 384) { const int v = tid >> 7, k = tid & 127; const float cv = (v < 2) ? P.in[1][v * DM + kc * 128 + k] : P.in[3][kc * 128 + k]; sv[tid] = siluf(cv); }
            __syncthreads();
            const int col = jc * 256 + (tid & 255), kh = tid >> 8;
            const float* w = P.in[4] + (size_t)l * DM * 6144 + (size_t)(kc * 128 + kh * 64) * 6144 + col;
            float a0 = 0.f, a1 = 0.f, a2 = 0.f;
#pragma unroll 8
            for (int k = 0; k < 64; ++k) { const float wv = w[(size_t)k * 6144]; a0 += sv[kh * 64 + k] * wv; a1 += sv[128 + kh * 64 + k] * wv; a2 += sv[256 + kh * 64 + k] * wv; }
            if (kh == 1) { red[(tid & 255) * 3 + 0] = a0; red[(tid & 255) * 3 + 1] = a1; red[(tid & 255) * 3 + 2] = a2; }
            __syncthreads();
            if (kh == 0) { float* dst = (float*)(ws + WS_ADAP) + (size_t)((l * 8 + kc) * 3) * 6144 + col;
                dst[0] = a0 + red[tid * 3 + 0]; dst[6144] = a1 + red[tid * 3 + 1]; dst[2 * 6144] = a2 + red[tid * 3 + 2]; }
            __syncthreads();
            continue;
        }
        r -= N_ADA;
        if (r < N_M2) {
            const int l = r / 64, g = (r % 64) / 16, nt = r % 16;
            const float* wf = P.in[13] + (size_t)l * 256 * 256 + (size_t)g * 64 * 256;
            const float* wo = P.in[11] + (size_t)l * DM * DM + (size_t)256 * DM + nt * 64;
            LAS float* wfs = scr;
            LAS float* wos = scr + 64 * 132;
            LAS float* Pm = wos + 128 * 64;
            LAS float* cst = Pm + 4096;
            const int n = tid & 63, mg = tid >> 6;
            float acc[8];
#pragma unroll
            for (int i = 0; i < 8; ++i) acc[i] = 0.f;
            for (int h2 = 0; h2 < 2; ++h2) {
#pragma unroll
                for (int k = 0; k < 16; ++k) { const int idx = tid + k * NTHREADS; { const int r_ = idx >> 7, c_ = idx & 127; wfs[r_ * 132 + c_] = wf[(size_t)r_ * 256 + h2 * 128 + c_]; }
                                               { const int r_ = idx >> 6, c_ = idx & 63; wos[r_ * 64 + c_] = wo[(size_t)(h2 * 128 + r_) * DM + c_]; } }
                __syncthreads();
                for (int q = 0; q < 128; q += 4) { const float w0 = wos[(q + 0) * 64 + n], w1 = wos[(q + 1) * 64 + n], w2 = wos[(q + 2) * 64 + n], w3 = wos[(q + 3) * 64 + n];
#pragma unroll
                    for (int i = 0; i < 8; ++i) { const f32x4 f4 = *(const LAS f32x4*)(wfs + (mg * 8 + i) * 132 + q); acc[i] += (f4[0] * w0 + f4[1] * w1) + (f4[2] * w2 + f4[3] * w3); } }
                __syncthreads();
            }
#pragma unroll
            for (int i = 0; i < 8; ++i) Pm[(mg * 8 + i) * 64 + n] = acc[i];
            if (tid < 64) cst[tid] = cospif((float)tid * (1.f / 32.f));
            __syncthreads();
            bf16_t* wot = (bf16_t*)(ws + WS_W + (size_t)l * SZ_WL + SZ_WIN);
            for (int rr = mg; rr < 128; rr += 8) { const int p = rr >> 6, j = rr & 63; float s = 0.f;
                for (int m = 0; m < 64; ++m) { const int a = (m * j) & 63; const float cs = p ? cst[(a + 48) & 63] : cst[a];
                    s += cs * Pm[m * 64 + n]; }
                wot[(size_t)(nt * 64 + n) * KOUT + 768 + p * 256 + g * 64 + j] = (bf16_t)f2bf(s * 0.125f); }
            __syncthreads();
            continue;
        }
        r -= N_M2;
        {
            const int NT = 64 * 512; const int gi = r * 512 + tid;
            bf16_t* TA = (bf16_t*)(ws + WS_TA); bf16_t* TC = (bf16_t*)(ws + WS_TC); bf16_t* TX = (bf16_t*)(ws + WS_TCTX); float* RP = (float*)(ws + WS_ROPE);
            for (int i = gi; i < 128 * 64; i += NT) { const int rr = i >> 6, t = i & 63; const int a = ((rr & 63) * t) & 63; float s, c; sincospif((float)a * (1.f / 32.f), &s, &c); TA[i] = (bf16_t)f2bf(rr < 64 ? c : -s); }
            for (int i = gi; i < 256 * 256; i += NT) { const int rr = i >> 8, cc = i & 255; const int p = rr >> 7, k2 = rr & 127, pp = cc >> 7, t2 = cc & 127; const int a = (k2 * t2) & 127;
                float s, c; sincospif((float)a * (1.f / 64.f), &s, &c); const float sc = 0.011048543456039806f;
                const float v = (p == 0) ? (pp == 0 ? c : s) : (pp == 0 ? -s : c); TC[i] = (bf16_t)f2bf(v * sc); }
            for (int i = gi; i < 512 * 256; i += NT) { const int rr = i >> 8, t = i & 255; const int p = rr >> 8, k = rr & 255; const int a = (k * t) & 255;
                float s, c; sincospif((float)a * (1.f / 128.f), &s, &c); TX[i] = (bf16_t)f2bf((p == 0 ? c : -s) * 0.0625f); }
            for (int i = gi; i < 128 * 16; i += NT) { const int pos = i >> 4, fi = i & 15; const float fr = powf(10000.f, -(float)fi * (1.f / 16.f)); const float ang = (float)pos * fr;
                RP[2 * i] = cosf(ang); RP[2 * i + 1] = sinf(ang); }
        }
    }
}

__device__ __forceinline__ float ada_value(const Params& P, int l, int v, int col) {
    const float* adap = (const float*)(P.ws + WS_ADAP); float s = P.in[5][l * 6144 + col];
#pragma unroll
    for (int kc = 0; kc < 8; ++kc) s += adap[(size_t)((l * 8 + kc) * 3 + v) * 6144 + col];
    return s;
}
template <bool FINAL>
__device__ __forceinline__ void load_mod(LAS float* dst, const Params& P, int l, int kind, int tid) {
    const float* adaf = (const float*)(P.ws + WS_ADAF);
    for (int i = tid; i < 3 * 1024; i += NTHREADS) { const int v = i >> 10, j = i & 1023, col = kind * 1024 + j;
        dst[i] = FINAL ? adaf[(size_t)(l * 3 + v) * 6144 + col] : ada_value(P, l, v, col); }
}
struct RowIn { f32x4 x[4]; u32x2 d[4]; };
__device__ __forceinline__ void row_load(RowIn& r, const float* xin, const bf16_t* delta, int lane) {
#pragma unroll
    for (int i = 0; i < 4; ++i) { r.x[i] = *(const f32x4*)(xin + lane * 4 + 256 * i); r.d[i] = delta ? *(const u32x2*)(delta + lane * 4 + 256 * i) : (u32x2){0u, 0u}; }
}
__device__ __forceinline__ void row_pass(const RowIn& rin, const bf16_t* delta, int npart, size_t pstride, const float* gpost, const LAS float* gt, float* xout,
                                         const float* gpre, const LAS float* sc, const LAS float* sh, bf16_t* aout, int lane) {
    f32x4 x[4];
#pragma unroll
    for (int i = 0; i < 4; ++i) x[i] = rin.x[i];
    if (delta) {
        f32x4 d[4]; float ss = 0.f;
#pragma unroll
        for (int i = 0; i < 4; ++i) { const u32x2 w = rin.d[i]; d[i] = (f32x4){bflo(w.x), bfhi(w.x), bflo(w.y), bfhi(w.y)};
            for (int pp = 1; pp < npart; ++pp) { const u32x2 w2 = *(const u32x2*)(delta + (size_t)pp * pstride + lane * 4 + 256 * i); d[i] = d[i] + (f32x4){bflo(w2.x), bfhi(w2.x), bflo(w2.y), bfhi(w2.y)}; }
            ss += (d[i][0] * d[i][0] + d[i][1] * d[i][1]) + (d[i][2] * d[i][2] + d[i][3] * d[i][3]); }
        const float rstd = rsqrtf(wave_sum(ss) * (1.f / DM) + EPS);
#pragma unroll
        for (int i = 0; i < 4; ++i) { const f32x4 g = *(const f32x4*)(gpost + lane * 4 + 256 * i); const f32x4 t = *(const LAS f32x4*)(gt + lane * 4 + 256 * i);
            x[i] = x[i] + t * (d[i] * rstd * g); }
    }
    if (xout) {
#pragma unroll
        for (int i = 0; i < 4; ++i) *(f32x4*)(xout + lane * 4 + 256 * i) = x[i];
    }
    if (aout) {
        float ss = 0.f;
#pragma unroll
        for (int i = 0; i < 4; ++i) ss += (x[i][0] * x[i][0] + x[i][1] * x[i][1]) + (x[i][2] * x[i][2] + x[i][3] * x[i][3]);
        const float rstd = rsqrtf(wave_sum(ss) * (1.f / DM) + EPS);
#pragma unroll
        for (int i = 0; i < 4; ++i) { const f32x4 g = *(const f32x4*)(gpre + lane * 4 + 256 * i); const f32x4 s1 = *(const LAS f32x4*)(sc + lane * 4 + 256 * i); const f32x4 s0 = *(const LAS f32x4*)(sh + lane * 4 + 256 * i);
            const f32x4 y = (x[i] * rstd * g) * (s1 + 1.f) + s0; u32x2 w; w.x = pk2(y[0], y[1]); w.y = pk2(y[2], y[3]);
            *(u32x2*)(aout + lane * 4 + 256 * i) = w; }
    }
}
__device__ __forceinline__ void phase_rows(const Params& P_, LAS unsigned char* lds, int mode, int l, int W0) {
    const Params& P = *kparams();
    const int tid = opaque_tid(W0), lane = tid & 63, wave = tid >> 6;
    LAS float* m0 = (LAS float*)lds;
    LAS float* m1 = m0 + 3072; LAS float* m2 = m1 + 3072;
    bf16_t* A = (bf16_t*)(P.ws + WS_A);
    float* hctx = (float*)(P.ws + WS_HCTX);
    if (mode == 0) { load_mod<false>(m1, P, 0, 1, tid); load_mod<false>(m2, P, 0, 0, tid);
        float* adaf = (float*)(P.ws + WS_ADAF);
        for (int i = blockIdx.x * NTHREADS + tid; i < 2 * 3 * 6144; i += gridDim.x * NTHREADS) { const int l_ = i / (3 * 6144), r_ = i % (3 * 6144); adaf[i] = ada_value(P, l_, r_ / 6144, r_ % 6144); } }
    else if (mode == 1) { load_mod<true>(m0, P, l, 2, tid); load_mod<true>(m1, P, l, 4, tid); load_mod<true>(m2, P, l, 3, tid); }
    else { load_mod<true>(m0, P, l, 5, tid); if (l + 1 < DEPTH) { load_mod<true>(m1, P, l + 1, 1, tid); load_mod<true>(m2, P, l + 1, 0, tid); } }
    __syncthreads();
    const int nrows = (mode == 0 || l == 0) ? MALL : MLAT;
    const int gw = blockIdx.x * NWAVES + wave, NGW = gridDim.x * NWAVES;
#define ROW_PTRS(row_, xin_, delta_) do { const bool lat_ = (row_) < MLAT; \
        if (mode == 0) { xin_ = lat_ ? P.in[0] + (size_t)(row_) * DM : P.in[2] + (size_t)((row_) - MLAT) * DM; delta_ = nullptr; } \
        else if (mode == 1) { xin_ = (l == 0) ? (lat_ ? P.in[0] + (size_t)(row_) * DM : P.in[2] + (size_t)((row_) - MLAT) * DM) : (P.out + (size_t)(row_) * DM); \
            delta_ = (!lat_ && l == 0) ? (const bf16_t*)(P.ws + WS_R2) + (size_t)((row_) - MLAT) * DM : (const bf16_t*)(P.ws + WS_BIG) + (size_t)(row_) * DM; } \
        else { xin_ = lat_ ? P.out + (size_t)(row_) * DM : hctx + (size_t)((row_) - MLAT) * DM; \
            delta_ = (!lat_ && l == 0) ? (const bf16_t*)(P.ws + WS_MIX) + (size_t)((row_) - MLAT) * DM : (const bf16_t*)(P.ws + WS_R2) + (size_t)(row_) * DM; } } while (0)
    RowIn cur, nxt;
    if (gw < nrows) { const float* xi; const bf16_t* de; ROW_PTRS(gw, xi, de); row_load(cur, xi, de, lane); }
    for (int row = gw; row < nrows; row += NGW) {
        const bool lat = row < MLAT; const int mid = row < NSEQ ? 0 : (lat ? 1 : 2);
        const float* xin; const bf16_t* delta; ROW_PTRS(row, xin, delta);
        if (row + NGW < nrows) { const float* xi; const bf16_t* de; ROW_PTRS(row + NGW, xi, de); row_load(nxt, xi, de, lane); }
        float* xout = nullptr; const float* gpost = nullptr; const float* gpre = nullptr; bf16_t* aout = nullptr;
        if (mode == 0) { gpre = P.in[6]; aout = A + (size_t)row * DM; }
        else if (mode == 1) { xout = lat ? P.out + (size_t)row * DM : hctx + (size_t)(row - MLAT) * DM; gpost = P.in[7] + l * DM; gpre = P.in[8] + l * DM; aout = A + (size_t)row * DM; }
        else { xout = const_cast<float*>(xin); gpost = P.in[9] + l * DM; if (l + 1 < DEPTH) { gpre = P.in[6] + (l + 1) * DM; aout = A + (size_t)row * DM; } }
        int npart = 1; const size_t pstride = (size_t)512 * DM;
        if (!lat && l == 0) { if (mode == 1) npart = 5; else if (mode == 2) npart = 11; }
        row_pass(cur, delta, npart, pstride, gpost, m0 + mid * 1024, xout, gpre, m1 + mid * 1024, m2 + mid * 1024, aout, lane);
        cur = nxt;
    }
#undef ROW_PTRS
}

template <int MAXIT>
__device__ __forceinline__ void stage_vt(LAS bf16_t* vt, int stride, int koff, const bf16_t* src0, int nkeys, int vlo, int vhi, int tid) {
    bf16x8 v0[MAXIT], v1[MAXIT];
#pragma unroll
    for (int i = 0; i < MAXIT; ++i) { const int u = tid + i * NTHREADS; const int kk = (u >> 3) * 2, dg = u & 7;
        v0[i] = (bf16x8){0, 0, 0, 0, 0, 0, 0, 0}; v1[i] = v0[i];
        if (u < nkeys * 4) { if (kk >= vlo && kk < vhi) v0[i] = *(const bf16x8*)(src0 + (ptrdiff_t)kk * DIN + dg * 8);
                             if (kk + 1 >= vlo && kk + 1 < vhi) v1[i] = *(const bf16x8*)(src0 + (ptrdiff_t)(kk + 1) * DIN + dg * 8); } }
#pragma unroll
    for (int i = 0; i < MAXIT; ++i) { const int u = tid + i * NTHREADS; const int kk = (u >> 3) * 2, dg = u & 7;
        if (u < nkeys * 4) {
#pragma unroll
            for (int e = 0; e < 8; ++e) *(LAS unsigned*)(vt + (dg * 8 + e) * stride + koff + kk) = (unsigned)(unsigned short)v0[i][e] | ((unsigned)(unsigned short)v1[i][e] << 16); } }
}

constexpr int VTS_NA = 584, VTS_SWA = 408, VTS_CTX = 264, VTS_CTXS = 296;

#define MEMBAR() asm volatile("" ::: "memory")
#define SCHEDBAR() __builtin_amdgcn_sched_barrier(0)
template <int NTILE>
__device__ __forceinline__ void softmax_pv_seg(f32x4 (&s)[NTILE], float& m, float& sum, f32x4 (&o)[4], const LAS bf16_t* vb, int vs, int ibase, int istep, int l15) {
    float mx = s[0][0];
#pragma unroll
    for (int j = 0; j < NTILE; ++j) mx = fmaxf(mx, fmaxf(fmaxf(s[j][0], s[j][1]), fmaxf(s[j][2], s[j][3])));
    mx = fmaxf(mx, __shfl_xor(mx, 16)); mx = fmaxf(mx, __shfl_xor(mx, 32));
    const float mn = fmaxf(m, mx);
    const float resc = __expf(m - mn);
    m = mn; sum *= resc;
#pragma unroll
    for (int mt = 0; mt < 4; ++mt) o[mt] = o[mt] * resc;
    float ps = 0.f;
#pragma unroll
    for (int j = 0; j < NTILE; ++j) {
#pragma unroll
        for (int e = 0; e < 4; ++e) { const float p = __expf(s[j][e] - mn); s[j][e] = p; ps += p; } }
    sum += ps;
#pragma unroll
    for (int jj = 0; jj < NTILE / 2; ++jj) {
        const f32x4 p0 = s[2 * jj], p1 = s[2 * jj + 1];
        u32x4 pw; pw.x = pk2(p0[0], p0[1]); pw.y = pk2(p0[2], p0[3]); pw.z = pk2(p1[0], p1[1]); pw.w = pk2(p1[2], p1[3]);
        const bf16x8 pf = __builtin_bit_cast(bf16x8, pw);
        const int i0x = ibase + istep * jj, i1x = i0x + 16;
#pragma unroll
        for (int mt = 0; mt < 4; ++mt) { const LAS bf16_t* vr = vb + (16 * mt + l15) * vs;
            const u32x2 v0 = *(const LAS u32x2*)(vr + i0x), v1 = *(const LAS u32x2*)(vr + i1x);
            u32x4 vw; vw.x = v0.x; vw.y = v0.y; vw.z = v1.x; vw.w = v1.y;
            o[mt] = __builtin_amdgcn_mfma_f32_16x16x32_bf16(__builtin_bit_cast(bf16x8, vw), pf, o[mt], 0, 0, 0); }
    }
}
template <int MODE>
__device__ __forceinline__ void attn_wave(const bf16_t* U, bf16_t* MIX, const LAS bf16_t* vtl, const LAS bf16_t* vtc, const LAS float* rpb,
                                          int b, int qrow  , int qcol_u, int kcol_u, int ocol, bool has_sink, float sinkv,
                                          int a0, int a1, int a2, int a3  , int lane) {
    constexpr int NT = MODE == 1 ? 18 : 16;
    constexpr int VSL = MODE == 0 ? VTS_NA : VTS_SWA, VSC = MODE == 1 ? VTS_CTXS : VTS_CTX;
    const int l15 = lane & 15, q = lane >> 4;
    const bf16_t* qp = U + (size_t)(qrow + l15) * DIN + qcol_u + 8 * q;
    const bf16x8 qf0 = *(const bf16x8*)qp, qf1 = *(const bf16x8*)(qp + 32);
    const float NEG = -__builtin_inff();
    float m = NEG, sum = 0.f;
    f32x4 o[4];
#pragma unroll
    for (int mt = 0; mt < 4; ++mt) o[mt] = (f32x4){0.f, 0.f, 0.f, 0.f};
    const int r = a0, cb = a1, rs = a2, rsA = a3;
    const int bs = min(max(16 * cb - 8, 0), 32), qc = cb * 16 + l15, cs = min(max(qc - 8, 0), 48);
    const int i0 = a0, tq = i0 + l15;
#pragma unroll 1
    for (int seg = (MODE == 2 ? 1 : 0); seg < 2; ++seg) {
        f32x4 s[NT];
#pragma unroll
        for (int j = 0; j < NT; ++j) {
            int krow;
            if (seg == 0) { if (MODE == 0) krow = b * NSEQ + (rs + (j >> 1)) * 64 + bs + 16 * (j & 1) + l15; else krow = b * NSEQ + min(max(i0 - 128 + 16 * j + l15, 0), NSEQ - 1); }
            else krow = MLAT + b * NCTX + (j < 16 ? 16 * j : 240) + l15;
            const bf16_t* kp = U + (size_t)krow * DIN + kcol_u + 8 * q;
            const bf16x8 k0 = *(const bf16x8*)kp, k1 = *(const bf16x8*)(kp + 32);
            f32x4 t = {0.f, 0.f, 0.f, 0.f};
            t = __builtin_amdgcn_mfma_f32_16x16x32_bf16(k0, qf0, t, 0, 0, 0); t = __builtin_amdgcn_mfma_f32_16x16x32_bf16(k1, qf1, t, 0, 0, 0);
#pragma unroll
            for (int e = 0; e < 4; ++e) {
                float v = t[e] * 0.125f; bool ok = (j < 16);
                if (seg == 0) {
                    if (MODE == 0) { const int kr = rs + (j >> 1), kc = bs + 16 * (j & 1) + 4 * q + e; ok = (kc >= cs) && (kc < cs + 16);
                        const int dc = min(max(kc - qc + 15, 0), 30); v += rpb[(kr - r + 7) * 31 + dc]; }
                    else if (MODE == 1) { const int sp = i0 - 128 + 16 * j + 4 * q + e; const int rel = sp - tq; ok = (rel <= 128) && (rel >= -128) && (sp >= 0) && (sp < NSEQ); }
                }
                t[e] = ok ? v : NEG; }
            s[j] = t; if ((j & 7) == 7) __builtin_amdgcn_sched_barrier(0); }
        const LAS bf16_t* vb = seg ? vtc : vtl; const int vs = seg ? VSC : VSL;
        int ibase, istep;
        if (seg) { ibase = 4 * q; istep = 32; }
        else if (MODE == 0) { ibase = (rs - rsA) * 64 + bs + 4 * q; istep = 64; }
        else { ibase = a1 + 4 * q; istep = 32; }
        softmax_pv_seg<NT>(s, m, sum, o, vb, vs, ibase, istep, l15);
    }
    sum += __shfl_xor(sum, 16); sum += __shfl_xor(sum, 32);
    if (has_sink) { const float mn = fmaxf(m, sinkv); const float resc = __expf(m - mn); sum = sum * resc + __expf(sinkv - mn);
#pragma unroll
        for (int mt = 0; mt < 4; ++mt) o[mt] = o[mt] * resc; }
    float inv = 1.f / sum;
    if ((DBG_ZERO & 1) && (MODE == 0 || (MODE == 2 && !has_sink))) inv = 0.f;
    if ((DBG_ZERO & 2) && (MODE == 1 || (MODE == 2 && has_sink))) inv = 0.f;
    bf16_t* op = MIX + (size_t)(qrow + l15) * KOUT + ocol + 4 * q;
#pragma unroll
    for (int mt = 0; mt < 4; ++mt) { u32x2 w; w.x = pk2(o[mt][0] * inv, o[mt][1] * inv); w.y = pk2(o[mt][2] * inv, o[mt][3] * inv); *(u32x2*)(op + 16 * mt) = w; }
}

__device__ __forceinline__ void na_item(const Params& P, LAS unsigned char* lds, int l, int item, int W0) {
    const int tid = opaque_tid(W0), lane = tid & 63, wave = tid >> 6;
    const int b = item >> 8, h = (item >> 6) & 3, rp = item & 63, r0 = 2 * rp;
    const bf16_t* U = (const bf16_t*)(P.ws + WS_BIG); bf16_t* MIX = (bf16_t*)(P.ws + WS_MIX);
    LAS bf16_t* vtl = (LAS bf16_t*)lds; LAS bf16_t* vtc = vtl + 64 * VTS_NA; LAS float* rpb = (LAS float*)(vtc + 64 * VTS_CTX);
    const int rsA = min(max(r0 - 4, 0), 120); const int nrows = min(9, 128 - rsA);
    stage_vt<5>(vtl, VTS_NA, 0, U + (size_t)(b * NSEQ + rsA * 64) * DIN + C_VA + h * 64, nrows * 64, 0, nrows * 64, tid);
    stage_vt<2>(vtc, VTS_CTX, 0, U + (size_t)(MLAT + b * NCTX) * DIN + C_VA + h * 64, 256, 0, 256, tid);
    for (int i = tid; i < 15 * 31; i += NTHREADS) rpb[i] = P.in[12][(size_t)(l * 4 + h) * 465 + i];
    __syncthreads();
    const int r = r0 + (wave >> 2), cb = wave & 3; const int rs = min(max(r - 4, 0), 120);
    attn_wave<0>(U, MIX, vtl, vtc, rpb, b, b * NSEQ + r * 64 + cb * 16, C_QA + h * 64, C_KA + h * 64, O_A + h * 64, false, 0.f, r, cb, rs, rsA, lane);
    __syncthreads();
}
__device__ __forceinline__ void swa_item(const Params& P, LAS unsigned char* lds, int l, int item, int W0) {
    const int tid = opaque_tid(W0), lane = tid & 63, wave = tid >> 6;
    const int b = item >> 8, hq = (item >> 6) & 3, nb = item & 63, g = hq >> 1;
    const bf16_t* U = (const bf16_t*)(P.ws + WS_BIG); bf16_t* MIX = (bf16_t*)(P.ws + WS_MIX);
    LAS bf16_t* vtl = (LAS bf16_t*)lds; LAS bf16_t* vtc = vtl + 64 * VTS_SWA;
    const int tok0 = (nb - 1) * 128;
    stage_vt<4>(vtl, VTS_SWA, 0, U + ((ptrdiff_t)b * NSEQ + tok0) * DIN + C_VS + g * 64, 400, max(0, -tok0), min(400, NSEQ - tok0), tid);
    stage_vt<3>(vtc, VTS_CTXS, 0, U + (size_t)(MLAT + b * NCTX) * DIN + C_VS + g * 64, 288, 0, 256, tid);
    __syncthreads();
    const int i0 = nb * 128 + 16 * wave;
    attn_wave<1>(U, MIX, vtl, vtc, nullptr, b, b * NSEQ + i0, C_QS + hq * 64, C_KS + g * 64, O_C + hq * 64, true, P.in[14][l * 4 + hq], i0, 16 * wave, 0, 0, lane);
    __syncthreads();
}
__device__ __forceinline__ void ctxattn_item(const Params& P, LAS unsigned char* lds, int l, int item, int W0) {
    const int tid = opaque_tid(W0), lane = tid & 63, wave = tid >> 6;
    const bool swa = item >= 16; const int it = item & 15; const int b = it >> 3, hh = (it >> 1) & 3, half = it & 1;
    const bf16_t* U = (const bf16_t*)(P.ws + WS_BIG); bf16_t* MIX = (bf16_t*)(P.ws + WS_MIX);
    LAS bf16_t* vtc = (LAS bf16_t*)lds;
    const int vcol = swa ? C_VS + (hh >> 1) * 64 : C_VA + hh * 64;
    stage_vt<2>(vtc, VTS_CTX, 0, U + (size_t)(MLAT + b * NCTX) * DIN + vcol, 256, 0, 256, tid);
    __syncthreads();
    const int qrow = MLAT + b * NCTX + half * 128 + 16 * wave;
    if (swa) attn_wave<2>(U, MIX, nullptr, vtc, nullptr, b, qrow, C_QS + hh * 64, C_KS + (hh >> 1) * 64, O_C + hh * 64, true, P.in[14][l * 4 + hh], 0, 0, 0, 0, lane);
    else     attn_wave<2>(U, MIX, nullptr, vtc, nullptr, b, qrow, C_QA + hh * 64, C_KA + hh * 64, O_A + hh * 64, false, 0.f, 0, 0, 0, 0, lane);
    __syncthreads();
}

__device__ __forceinline__ float hgrn_lb(const Params& P, int l, int dir, int k256) {
    if (l == 0) return 0.f;
    const float l0 = P.in[15][(size_t)(dir * DEPTH + 0) * 256 + k256], l1 = P.in[15][(size_t)(dir * DEPTH + 1) * 256 + k256];
    return 1.f / (1.f + __expf(l0 - l1));
}
template <bool OUT>
__device__ __forceinline__ void hgrn_item(const Params& P, LAS unsigned char* lds, int l, int item, int W0) {
    const int tid = opaque_tid(W0), lane = tid & 63, wave = tid >> 6;
    const int b = item / NCHUNK, c = item % NCHUNK;
    const int h = wave & 3, dir = wave >> 2;
    const int row0 = c < 4 ? MLAT + b * NCTX + c * 64 : b * NSEQ + (c - 4) * 64;
    const int pos = dir == 0 ? c : (c < 4 ? 3 - c : 135 - c);
    const int chain = (b * 4 + h) * 2 + dir;
    const bf16_t* U = (const bf16_t*)(P.ws + WS_BIG);
    float* HL = (float*)(P.ws + WS_R2) + ((size_t)chain * NCHUNK + pos) * 4096;
    float* HD = (float*)(P.ws + WS_HD) + ((size_t)chain * NCHUNK + pos) * 64;
    LAS float* OB = (LAS float*)lds;
    LAS float* stg = (LAS float*)(lds + 65536) + wave * 2048;
    const float lb = hgrn_lb(P, l, dir, h * 64 + lane);
    const int fcol = (dir == 0 ? C_FF : C_FB) + h * 64 + lane;
    float S[64];
    if (OUT) {
        for (int i = tid; i < 4 * 64 * 64; i += NTHREADS) OB[i] = 0.f;
        if (c >= 4) {
#pragma unroll
            for (int j = 0; j < 64; ++j) S[j] = HL[j * 64 + lane];
        } else {
#pragma unroll
            for (int j = 0; j < 64; ++j) S[j] = 0.f;
            for (int pp = 0; pp < pos; ++pp) { const float* Lp = (const float*)(P.ws + WS_R2) + ((size_t)chain * NCHUNK + pp) * 4096; const float* Dp = (const float*)(P.ws + WS_HD) + ((size_t)chain * NCHUNK + pp) * 64;
#pragma unroll
                for (int j = 0; j < 64; ++j) S[j] = Dp[j] * S[j] + Lp[j * 64 + lane]; }
        }
        __syncthreads();
    } else {
#pragma unroll
        for (int j = 0; j < 64; ++j) S[j] = 0.f;
    }
    float D = 1.f;
    for (int sub = 0; sub < 4; ++sub) {
        float vv[16];
#pragma unroll
        for (int st = 0; st < 16; ++st) { const int step = sub * 16 + st; const int t = dir == 0 ? step : 63 - step; const bf16_t* ur = U + (size_t)(row0 + t) * DIN;
            const float fz = bf2f(ur[fcol]); const float f = lb + (1.f - lb) * sigmoidf_(fz); D *= f;
            stg[st * 128 + lane] = f;
            if (OUT) stg[st * 128 + 64 + lane] = siluf(bf2f(ur[C_QD + h * 64 + lane]));
            vv[st] = bf2f(ur[C_IV + h * 64 + lane]); }
#pragma unroll
        for (int st = 0; st < 16; ++st) { const float v = vv[st]; const LAS f32x4* fp = (const LAS f32x4*)(stg + st * 128); float oa = 0.f, ob = 0.f, oc = 0.f, od = 0.f;
#pragma unroll
            for (int j4 = 0; j4 < 16; ++j4) { if ((j4 & HG_BAR) == 0) MEMBAR(); const f32x4 f4 = fp[j4];
                S[4 * j4 + 0] = __builtin_fmaf(f4[0], S[4 * j4 + 0] - v, v); S[4 * j4 + 1] = __builtin_fmaf(f4[1], S[4 * j4 + 1] - v, v);
                S[4 * j4 + 2] = __builtin_fmaf(f4[2], S[4 * j4 + 2] - v, v); S[4 * j4 + 3] = __builtin_fmaf(f4[3], S[4 * j4 + 3] - v, v);
                if (OUT) { const f32x4 q4 = fp[16 + j4]; oa += S[4 * j4 + 0] * q4[0]; ob += S[4 * j4 + 1] * q4[1]; oc += S[4 * j4 + 2] * q4[2]; od += S[4 * j4 + 3] * q4[3]; } }
            if (OUT) { const int step = sub * 16 + st; const int t = dir == 0 ? step : 63 - step; atomicAdd((float*)(OB + (h * 64 + t) * 64 + lane), (oa + ob) + (oc + od)); } }
    }
    if (!OUT) {
#pragma unroll
        for (int j = 0; j < 64; ++j) HL[j * 64 + lane] = S[j];
        HD[lane] = D;
    } else {
        __syncthreads();
        bf16_t* MIX = (bf16_t*)(P.ws + WS_MIX);
        for (int p0 = wave; p0 < 256; p0 += 8 * NWAVES) {
            float gz[8], val[8];
#pragma unroll
            for (int i = 0; i < 8; ++i) { const int pr = p0 + i * NWAVES, hh = pr >> 6, t = pr & 63; gz[i] = bf2f(U[(size_t)(row0 + t) * DIN + C_GD + hh * 64 + lane]); val[i] = OB[(hh * 64 + t) * 64 + lane]; }
#pragma unroll
            for (int i = 0; i < 8; ++i) { const int pr = p0 + i * NWAVES, hh = pr >> 6, t = pr & 63;
                const float rstd = rsqrtf(wave_sum(val[i] * val[i]) * (1.f / 64.f) + EPS);
                const float gn = P.in[16][l * 256 + hh * 64 + lane];
                MIX[(size_t)(row0 + t) * KOUT + O_D + hh * 64 + lane] = (bf16_t)f2bf((DBG_ZERO & 4) ? 0.f : val[i] * rstd * gn * siluf(gz[i])); }
        }
        __syncthreads();
    }
}

__device__ __forceinline__ void hgrn_state_item(const Params& P, LAS unsigned char* lds, int l, int item, int W0) {
    const int tid = opaque_tid(W0), lane = tid & 63, wave = tid >> 6, l15 = lane & 15, q = lane >> 4;
    const int b = item / NCHUNK, c = item % NCHUNK;
    const int h = wave & 3, dir = wave >> 2;
    const int row0 = c < 4 ? MLAT + b * NCTX + c * 64 : b * NSEQ + (c - 4) * 64;
    const int pos = dir == 0 ? c : (c < 4 ? 3 - c : 135 - c);
    const int chain = (b * 4 + h) * 2 + dir;
    const bf16_t* U = (const bf16_t*)(P.ws + WS_BIG);
    float* HL = (float*)(P.ws + WS_R2) + ((size_t)chain * NCHUNK + pos) * 4096;
    float* HD = (float*)(P.ws + WS_HD) + ((size_t)chain * NCHUNK + pos) * 64;
    constexpr int RS = 72;
    LAS bf16_t* VT = (LAS bf16_t*)lds + h * 64 * RS;
    LAS bf16_t* KH = (LAS bf16_t*)lds + 4 * 64 * RS + wave * 64 * RS;
    const float lb = hgrn_lb(P, l, dir, h * 64 + lane);
    const int fcol = (dir == 0 ? C_FF : C_FB) + h * 64 + lane;
    float p = 1.f;
    for (int sb = 0; sb < 4; ++sb) {
        float fz[16]; unsigned short vv[16];
#pragma unroll
        for (int i = 0; i < 16; ++i) { const int step = 63 - (sb * 16 + i); const int t = dir == 0 ? step : 63 - step; const bf16_t* ur = U + (size_t)(row0 + t) * DIN;
            fz[i] = bf2f(ur[fcol]); vv[i] = (dir == 0) ? ur[C_IV + h * 64 + lane] : (unsigned short)0; }
#pragma unroll
        for (int i = 0; i < 16; i += 2) {
            const int st0 = 63 - (sb * 16 + i), st1 = st0 - 1; const int t0 = dir == 0 ? st0 : 63 - st0, t1 = dir == 0 ? st1 : 63 - st1;
            const float f0 = lb + (1.f - lb) * sigmoidf_(fz[i]); const float k0 = (1.f - f0) * p; p *= f0;
            const float f1 = lb + (1.f - lb) * sigmoidf_(fz[i + 1]); const float k1 = (1.f - f1) * p; p *= f1;
            const int te = t0 < t1 ? t0 : t1; const unsigned lo = f2bf(t0 < t1 ? k0 : k1), hi = f2bf(t0 < t1 ? k1 : k0);
            *(LAS unsigned*)(KH + lane * RS + te) = lo | (hi << 16);
            if (dir == 0) { const unsigned vlo = t0 < t1 ? vv[i] : vv[i + 1], vhi = t0 < t1 ? vv[i + 1] : vv[i]; *(LAS unsigned*)(VT + lane * RS + te) = vlo | (vhi << 16); }
        }
    }
    HD[lane] = p;
    __syncthreads();
    f32x4 acc[4][4];
#pragma unroll
    for (int mt = 0; mt < 4; ++mt)
#pragma unroll
        for (int nt = 0; nt < 4; ++nt) acc[mt][nt] = (f32x4){0.f, 0.f, 0.f, 0.f};
#pragma unroll
    for (int ks = 0; ks < 2; ++ks) {
        bf16x8 bfr[4];
#pragma unroll
        for (int nt = 0; nt < 4; ++nt) bfr[nt] = *(const LAS bf16x8*)(VT + (16 * nt + l15) * RS + 32 * ks + 8 * q);
#pragma unroll
        for (int mt = 0; mt < 4; ++mt) { const bf16x8 afr = *(const LAS bf16x8*)(KH + (16 * mt + l15) * RS + 32 * ks + 8 * q);
#pragma unroll
            for (int nt = 0; nt < 4; ++nt) acc[mt][nt] = __builtin_amdgcn_mfma_f32_16x16x32_bf16(afr, bfr[nt], acc[mt][nt], 0, 0, 0); }
    }
#pragma unroll
    for (int mt = 0; mt < 4; ++mt)
#pragma unroll
        for (int nt = 0; nt < 4; ++nt)
            *(f32x4*)(HL + ((mt * 4 + nt) * 64 + lane) * 4) = acc[mt][nt];
    __syncthreads();
}

__device__ __forceinline__ float frcp(float x) { return __builtin_amdgcn_rcpf(x); }
__device__ __forceinline__ float fsigmoid(float a) { return frcp(1.f + __expf(-a)); }
__device__ __forceinline__ float fsilu(float a) { return a * frcp(1.f + __expf(-a)); }
#define HG_LOAD_SB(SB) do { if (dir == 0) { const bf16_t* up = Ub + (size_t)((SB) * 16) * DIN; \
        _Pragma("unroll") for (int s_ = 0; s_ < 16; ++s_) { nfz[s_] = up[C_FF]; nqv[s_] = up[C_QD]; nvv[s_] = up[C_IV]; up += DIN; } } \
    else { const bf16_t* up = Ub + (size_t)(63 - (SB) * 16) * DIN; \
        _Pragma("unroll") for (int s_ = 0; s_ < 16; ++s_) { nfz[s_] = up[C_FB]; nqv[s_] = up[C_QD]; nvv[s_] = up[C_IV]; up -= DIN; } } } while (0)
__device__ __forceinline__ void hgrn_out_item(const Params& P, LAS unsigned char* lds, int l, int item, int W0) {
    const int tid = opaque_tid(W0), lane = tid & 63, wave = tid >> 6, l15 = lane & 15, q = lane >> 4;
    const int b = item / NCHUNK, c = item % NCHUNK;
    const int h = wave & 3, dir = wave >> 2;
    const int row0 = c < 4 ? MLAT + b * NCTX + c * 64 : b * NSEQ + (c - 4) * 64;
    const int pos = dir == 0 ? c : (c < 4 ? 3 - c : 135 - c);
    const int chain = (b * 4 + h) * 2 + dir;
    const bf16_t* U = (const bf16_t*)(P.ws + WS_BIG);
    const float* HLb = (const float*)(P.ws + WS_R2) + (size_t)chain * NCHUNK * 4096;
    const float* HDb = (const float*)(P.ws + WS_HD) + (size_t)chain * NCHUNK * 64;
    constexpr int OS = 66;
    LAS bf16_t* OBd = (LAS bf16_t*)lds + dir * (4 * 64 * OS);
    constexpr int QS = 68, ES = 20;
    LAS unsigned char* wb = lds + 2 * 4 * 64 * OS * 2 + wave * 9728;
    LAS bf16_t* QT = (LAS bf16_t*)wb;
    LAS bf16_t* KT = QT + 16 * QS;
    LAS bf16_t* KE = KT + 16 * QS;
    LAS bf16_t* VT = KE + 64 * ES;
    LAS float* A15 = (LAS float*)(VT + 64 * ES);
    const float lb = hgrn_lb(P, l, dir, h * 64 + lane);
    const int fcol = (dir == 0 ? C_FF : C_FB) + h * 64 + lane;
    f32x4 S[4][4];
    if (c >= 4) { const float* Hp = HLb + (size_t)pos * 4096;
#pragma unroll
        for (int mt = 0; mt < 4; ++mt)
#pragma unroll
            for (int nt = 0; nt < 4; ++nt)
                S[mt][nt] = *(const f32x4*)(Hp + ((mt * 4 + nt) * 64 + lane) * 4);
    } else {
#pragma unroll
        for (int mt = 0; mt < 4; ++mt)
#pragma unroll
            for (int nt = 0; nt < 4; ++nt) S[mt][nt] = (f32x4){0.f, 0.f, 0.f, 0.f};
        for (int pp = 0; pp < pos; ++pp) { const float* Lp = HLb + (size_t)pp * 4096; const float* Dp = HDb + pp * 64;
#pragma unroll
            for (int mt = 0; mt < 4; ++mt) { const f32x4 d4 = *(const f32x4*)(Dp + 16 * mt + 4 * q);
#pragma unroll
                for (int nt = 0; nt < 4; ++nt)
                    S[mt][nt] = d4 * S[mt][nt] + *(const f32x4*)(Lp + ((mt * 4 + nt) * 64 + lane) * 4); } }
    }
    __syncthreads();
    unsigned short nfz[16], nqv[16], nvv[16];
    const bf16_t* Ub = U + (size_t)row0 * DIN + h * 64 + lane;
    HG_LOAD_SB(0);
    for (int sb = 0; sb < 4; ++sb) {
        float fz[16], qv[16]; unsigned short vv[16];
#pragma unroll
        for (int s_ = 0; s_ < 16; ++s_) { fz[s_] = bf2f(nfz[s_]); qv[s_] = bf2f(nqv[s_]); vv[s_] = nvv[s_]; }
        if (sb < 3) HG_LOAD_SB(sb + 1);
        float a[16], kk[16]; float ap = 1.f;
#pragma unroll
        for (int s_ = 0; s_ < 16; ++s_) { const float f = lb + (1.f - lb) * fsigmoid(fz[s_]); ap *= f; a[s_] = fmaxf(ap, 1e-30f); kk[s_] = 1.f - f; }
        const float a15 = a[15];
        A15[lane] = a15;
#pragma unroll
        for (int s_ = 0; s_ < 16; s_ += 2) {
            const float ia0 = frcp(a[s_]), ia1 = frcp(a[s_ + 1]);
            const unsigned qp = pk2(fsilu(qv[s_]) * a[s_], fsilu(qv[s_ + 1]) * a[s_ + 1]), kp = pk2(kk[s_] * ia0, kk[s_ + 1] * ia1);
            QT[s_ * QS + lane] = (bf16_t)qp; QT[(s_ + 1) * QS + lane] = (bf16_t)(qp >> 16);
            KT[s_ * QS + lane] = (bf16_t)kp; KT[(s_ + 1) * QS + lane] = (bf16_t)(kp >> 16);
            *(LAS unsigned*)(KE + lane * ES + s_) = pk2(kk[s_] * a15 * ia0, kk[s_ + 1] * a15 * ia1);
            *(LAS unsigned*)(VT + lane * ES + s_) = (unsigned)vv[s_] | ((unsigned)vv[s_ + 1] << 16);
        }
        MEMBAR();
        bf16x8 qfr[2], kfr[2];
#pragma unroll
        for (int ks = 0; ks < 2; ++ks) {
            const u32x2 q0 = *(const LAS u32x2*)(QT + l15 * QS + 32 * ks + 4 * q), q1 = *(const LAS u32x2*)(QT + l15 * QS + 32 * ks + 16 + 4 * q);
            const u32x2 k0 = *(const LAS u32x2*)(KT + l15 * QS + 32 * ks + 4 * q), k1 = *(const LAS u32x2*)(KT + l15 * QS + 32 * ks + 16 + 4 * q);
            u32x4 qw; qw.x = q0.x; qw.y = q0.y; qw.z = q1.x; qw.w = q1.y; qfr[ks] = __builtin_bit_cast(bf16x8, qw);
            u32x4 kw; kw.x = k0.x; kw.y = k0.y; kw.z = k1.x; kw.w = k1.y; kfr[ks] = __builtin_bit_cast(bf16x8, kw);
        }
        f32x4 att = {0.f, 0.f, 0.f, 0.f};
        att = __builtin_amdgcn_mfma_f32_16x16x32_bf16(kfr[0], qfr[0], att, 0, 0, 0); att = __builtin_amdgcn_mfma_f32_16x16x32_bf16(kfr[1], qfr[1], att, 0, 0, 0);
#pragma unroll
        for (int e = 0; e < 4; ++e) att[e] = (4 * q + e <= l15) ? att[e] : 0.f;
        u32x4 pw; pw.x = pk2(att[0], att[1]); pw.y = pk2(att[2], att[3]); pw.z = 0u; pw.w = 0u;
        const bf16x8 pfr = __builtin_bit_cast(bf16x8, pw);
        f32x4 oT[4];
#pragma unroll
        for (int nt = 0; nt < 4; ++nt) {
            f32x4 o = {0.f, 0.f, 0.f, 0.f};
#pragma unroll
            for (int ks = 0; ks < 2; ++ks) { const f32x4 s0 = S[2 * ks][nt], s1 = S[2 * ks + 1][nt];
                u32x4 sw; sw.x = pk2(s0[0], s0[1]); sw.y = pk2(s0[2], s0[3]); sw.z = pk2(s1[0], s1[1]); sw.w = pk2(s1[2], s1[3]);
                o = __builtin_amdgcn_mfma_f32_16x16x32_bf16(__builtin_bit_cast(bf16x8, sw), qfr[ks], o, 0, 0, 0); }
            const u32x2 v0 = *(const LAS u32x2*)(VT + (16 * nt + l15) * ES + 4 * q);
            u32x4 vw; vw.x = v0.x; vw.y = v0.y; vw.z = 0u; vw.w = 0u;
            o = __builtin_amdgcn_mfma_f32_16x16x32_bf16(__builtin_bit_cast(bf16x8, vw), pfr, o, 0, 0, 0);
            oT[nt] = o;
        }
#pragma unroll
        for (int mt = 0; mt < 4; ++mt) { const f32x4 a4 = *(const LAS f32x4*)(A15 + 16 * mt + 4 * q);
            const u32x2 e0 = *(const LAS u32x2*)(KE + (16 * mt + l15) * ES + 4 * q);
            u32x4 ew; ew.x = e0.x; ew.y = e0.y; ew.z = 0u; ew.w = 0u; const bf16x8 efr = __builtin_bit_cast(bf16x8, ew);
#pragma unroll
            for (int nt = 0; nt < 4; ++nt) { const u32x2 v0 = *(const LAS u32x2*)(VT + (16 * nt + l15) * ES + 4 * q);
                u32x4 vw; vw.x = v0.x; vw.y = v0.y; vw.z = 0u; vw.w = 0u;
                S[mt][nt] = __builtin_amdgcn_mfma_f32_16x16x32_bf16(efr, __builtin_bit_cast(bf16x8, vw), S[mt][nt] * a4, 0, 0, 0); } }
        { const int step = sb * 16 + l15; const int t = dir == 0 ? step : 63 - step; LAS bf16_t* orow = OBd + (h * 64 + t) * OS + 4 * q;
#pragma unroll
          for (int nt = 0; nt < 4; ++nt) { *(LAS unsigned*)(orow + 16 * nt) = pk2(oT[nt][0], oT[nt][1]); *(LAS unsigned*)(orow + 16 * nt + 2) = pk2(oT[nt][2], oT[nt][3]); } }
        MEMBAR();
    }
    __syncthreads();
    {
        bf16_t* MIX = (bf16_t*)(P.ws + WS_MIX);
        for (int p0 = wave; p0 < 256; p0 += 8 * NWAVES) {
            float gz[8], val[8];
#pragma unroll
            for (int i = 0; i < 8; ++i) { const int pr = p0 + i * NWAVES, hh = pr >> 6, t = pr & 63; gz[i] = bf2f(U[(size_t)(row0 + t) * DIN + C_GD + hh * 64 + lane]); val[i] = bf2f(((const LAS bf16_t*)lds)[(hh * 64 + t) * OS + lane]) + bf2f(((const LAS bf16_t*)lds)[4 * 64 * OS + (hh * 64 + t) * OS + lane]); }
#pragma unroll
            for (int i = 0; i < 8; ++i) { const int pr = p0 + i * NWAVES, hh = pr >> 6, t = pr & 63;
                const float rstd = rsqrtf(wave_sum(val[i] * val[i]) * (1.f / 64.f) + EPS);
                const float gn = P.in[16][l * 256 + hh * 64 + lane];
                MIX[(size_t)(row0 + t) * KOUT + O_D + hh * 64 + lane] = (bf16_t)f2bf(val[i] * rstd * gn * fsilu(gz[i])); }
        }
    }
    __syncthreads();
}
__device__ __forceinline__ void hgrn_prefix_item(const Params& P, int item, int W0) {
    const int e = item * NTHREADS + opaque_tid(W0); const int chain = e >> 12, kv = e & 4095, k = 16 * (kv >> 10) + 4 * ((kv >> 6) & 3) + (kv & 3);
    float* HL = (float*)(P.ws + WS_R2) + (size_t)chain * NCHUNK * 4096 + kv;
    const float* HD = (const float*)(P.ws + WS_HD) + (size_t)chain * NCHUNK * 64 + k;
    float S = 0.f;
    for (int p0 = 0; p0 < NCHUNK; p0 += 12) { float tv[12], dv[12];
#pragma unroll
        for (int i = 0; i < 12; ++i) { tv[i] = HL[(size_t)(p0 + i) * 4096]; dv[i] = HD[(p0 + i) * 64]; }
#pragma unroll
        for (int i = 0; i < 12; ++i) { if (p0 + i >= 4) HL[(size_t)(p0 + i) * 4096] = S; S = dv[i] * S + tv[i]; } }
}

template <int MODE>
__device__ __forceinline__ void fnet_item(const Params& P, LAS unsigned char* lds, int item, int W0) {
    constexpr int KD = MODE == 0 ? 64 : 256, R = MODE == 0 ? 128 : (MODE == 1 ? 256 : 512), DS = KD + 8;
    const int tid = opaque_tid(W0), lane = tid & 63, wave = tid >> 6, l15 = lane & 15, q = lane >> 4;
    const bf16_t* U = (const bf16_t*)(P.ws + WS_BIG); bf16_t* MIX = (bf16_t*)(P.ws + WS_MIX); bf16_t* Y = (bf16_t*)(P.ws + WS_A);
    LAS bf16_t* DT = (LAS bf16_t*)lds;
    const bf16_t* T = (const bf16_t*)(P.ws + (MODE == 0 ? WS_TA : (MODE == 1 ? WS_TC : WS_TCTX)));
    const int b = MODE == 2 ? item : item >> (MODE == 0 ? 7 : 6);
    const int sub = MODE == 0 ? (item & 127) : (MODE == 1 ? (item & 63) : 0);
    for (int u = tid; u < KD * 16; u += NTHREADS) { const int kk = (u >> 5) * 2, cg8 = (u & 31) * 8; const bf16_t* src0; const bf16_t* src1;
        if (MODE == 0) { src0 = U + (size_t)(b * NSEQ + 128 * kk + sub) * DIN + C_UB + cg8; src1 = src0 + (size_t)128 * DIN; }
        else if (MODE == 1) { const int p = kk >> 7, t2 = kk & 127; src0 = Y + ((size_t)((b * 64 + sub) * 128 + t2) * 2 + p) * 256 + cg8; src1 = src0 + 512;
#ifdef DBG_CONSTSRC
            src0 = T + (size_t)kk * 256 + cg8; src1 = src0 + 256;
#endif
        }
        else { src0 = U + (size_t)(MLAT + b * NCTX + kk) * DIN + C_UB + cg8; src1 = src0 + DIN; }
        const bf16x8 v0 = *(const bf16x8*)src0, v1 = *(const bf16x8*)src1;
#pragma unroll
        for (int e = 0; e < 8; ++e) *(LAS unsigned*)(DT + (cg8 + e) * DS + kk) = (unsigned)(unsigned short)v0[e] | ((unsigned)(unsigned short)v1[e] << 16); }
    __syncthreads();
    bf16x8 df[2][KD / 32];
#pragma unroll
    for (int ct = 0; ct < 2; ++ct)
#pragma unroll
        for (int ks = 0; ks < KD / 32; ++ks) df[ct][ks] = *(const LAS bf16x8*)(DT + ((2 * wave + ct) * 16 + l15) * DS + 32 * ks + 8 * q);
    for (int rt = 0; rt < R / 32; ++rt) {
        f32x4 acc[2][2];
#pragma unroll
        for (int ct = 0; ct < 2; ++ct)
#pragma unroll
            for (int p = 0; p < 2; ++p) acc[ct][p] = (f32x4){0.f, 0.f, 0.f, 0.f};
#pragma unroll
        for (int ks = 0; ks < KD / 32; ++ks) {
            const bf16x8 t0 = *(const bf16x8*)(T + (size_t)(16 * rt + l15) * KD + 32 * ks + 8 * q);
            const bf16x8 t1 = *(const bf16x8*)(T + (size_t)(R / 2 + 16 * rt + l15) * KD + 32 * ks + 8 * q);
#pragma unroll
            for (int ct = 0; ct < 2; ++ct) { acc[ct][0] = __builtin_amdgcn_mfma_f32_16x16x32_bf16(df[ct][ks], t0, acc[ct][0], 0, 0, 0);
                                             acc[ct][1] = __builtin_amdgcn_mfma_f32_16x16x32_bf16(df[ct][ks], t1, acc[ct][1], 0, 0, 0); }
        }
        const int rr = 16 * rt + l15;
        float tc = 1.f, tsn = 0.f;
        if (MODE == 0) sincospif((float)(rr * sub) * (1.f / 4096.f), &tsn, &tc);
#pragma unroll
        for (int ct = 0; ct < 2; ++ct) { const int ch = (2 * wave + ct) * 16 + 4 * q; f32x4 re = acc[ct][0], im = acc[ct][1];
            if (MODE == 0) { const f32x4 r2 = re * tc + im * tsn, i2 = im * tc - re * tsn; re = r2; im = i2; }
            if ((DBG_ZERO & 8) && MODE != 0) { re = re * 0.f; im = im * 0.f; }
            if ((DBG_ZERO & 64) && MODE != 0) { im = im * 0.f; }
            if ((DBG_ZERO & 128) && MODE != 0) { re = re * 0.f; }
            u32x2 wr_, wi_; wr_.x = pk2(re[0], re[1]); wr_.y = pk2(re[2], re[3]); wi_.x = pk2(im[0], im[1]); wi_.y = pk2(im[2], im[3]);
            if (MODE == 0) { bf16_t* yp = Y + ((size_t)((b * 64 + rr) * 128 + sub) * 2) * 256 + ch; *(u32x2*)yp = wr_; *(u32x2*)(yp + 256) = wi_; }
            else { const size_t row = MODE == 1 ? (size_t)(b * NSEQ + sub + 64 * rr) : (size_t)(MLAT + b * NCTX + rr); bf16_t* mp = MIX + row * KOUT + O_Z + ch; *(u32x2*)mp = wr_; *(u32x2*)(mp + 256) = wi_; }
        }
    }
    __syncthreads();
}


__device__ __forceinline__ void phase_m1(const Params& P_, LAS unsigned char* lds, int l, int W0) {
    const Params& P = *kparams();
    const int bid = blockIdx.x;
    for (int k = 0; k < 3; ++k) {
        int type = -1, id = 0;
        if (k == 0) { type = 0; id = (bid >> 7) * NCHUNK + 4 + (bid & 127); }
        else if (k == 1) { if (bid < 8) { type = 0; id = (bid >> 2) * NCHUNK + (bid & 3); } else { type = 1; id = bid - 8; } }
        else { if (bid >= 8 && bid < 16) { type = 1; id = 248 + (bid - 8); } else if (l == 0 && (bid == 16 || bid == 17)) { type = 2; id = bid - 16; } }
        if (type == 0) hgrn_state_item(P, lds, l, id, W0); else if (type == 1) fnet_item<0>(P, lds, id, W0); else if (type == 2) fnet_item<2>(P, lds, id, W0);
    }
    na_item(P, lds, l, bid, W0);
}
__device__ __forceinline__ void phase_m2(const Params& P_, LAS unsigned char* lds, int l, int rep, int W0) {
    const Params& P = *kparams();
    const int bid = blockIdx.x;
    const int NW = (l == 0) ? 248 : 256, wb = (l == 0) ? bid - 8 : bid, NIT = 128 + 128 + 256 + 256 + ((l == 0) ? 32 : 0);
    if (wb < 0) { hgrn_out_item(P, lds, l, (bid >> 2) * NCHUNK + (bid & 3), W0); return; }
    for (int it = wb; it < NIT; it += NW) {
        if (it < 128) fnet_item<1>(P, lds, it, W0);
        else if (it < 256) { if (rep == 0) hgrn_prefix_item(P, it - 128, W0); }
        else if (it < 512) na_item(P, lds, l, 256 + (it - 256), W0);
        else if (it < 768) swa_item(P, lds, l, it - 512, W0);
        else ctxattn_item(P, lds, l, it - 768, W0);
    }
}
__device__ __forceinline__ void phase_m3(const Params& P_, LAS unsigned char* lds, int l, int W0) {
    const Params& P = *kparams();
    const int bid = blockIdx.x;
    for (int rep = 0; rep < ((DBG_DUP2 & 1) ? 2 : 1); ++rep) hgrn_out_item(P, lds, l, (bid >> 7) * NCHUNK + 4 + (bid & 127), W0);
    for (int rep = 0; rep < ((DBG_DUP2 & 2) ? 2 : 1); ++rep) swa_item(P, lds, l, 256 + bid, W0);
}

template <class Epi>
__device__ __forceinline__ void run_gemm(LAS unsigned char* lds, const bf16_t* A, const bf16_t* Bt, int M, int N, int K, const Epi& E, int W0) {
    pg8::Gemm g{A, Bt, M, N, K, K}; pg8::StaticOrder S; S.init(M, N, (int)gridDim.x, (int)blockIdx.x);
    pg8::gemm_phase<Epi, pg8::StaticOrder, true, true>((PG8_LAS unsigned char*)lds, g, S, E, W0);
    __syncthreads();
}
template <class Epi>
__device__ __forceinline__ void run_gemm_split(LAS unsigned char* lds, const bf16_t* A, const bf16_t* Bt, int M, int N, int K, int NS, const Epi& E, int W0) {
    pg8::Gemm g{A, Bt, M, N, K / NS, K}; pg8::SplitOrder S; S.init(M, N, NS, (int)gridDim.x, (int)blockIdx.x);
    pg8::gemm_phase<Epi, pg8::SplitOrder, true, true>((PG8_LAS unsigned char*)lds, g, S, E, W0);
    __syncthreads();
}

#define GAS __attribute__((address_space(1)))
#define XB_TMO      128
#define XB_XCNT(j)  (256  + 64 * (j))
#define XB_XSUB(j)  (1280 + 64 * (j))
#define XB_XGEN(j)  (2304 + 64 * (j))
#define XB_TOP      3328
#define XB_TOPGEN   3392
#define XCD_BAR_WORDS 3456
#define XB_SPIN_CAP (1u << 18)

__device__ __forceinline__ unsigned xb_ld(unsigned* p)              { return __hip_atomic_load(p, __ATOMIC_RELAXED, __HIP_MEMORY_SCOPE_AGENT); }
__device__ __forceinline__ unsigned xb_add(unsigned* p, unsigned v) { return __hip_atomic_fetch_add(p, v, __ATOMIC_RELAXED, __HIP_MEMORY_SCOPE_AGENT); }
__device__ __forceinline__ unsigned xb_xcc_id() { return (unsigned)__builtin_amdgcn_s_getreg((3 << 11) | 20) & 0xFu; }
#define XB_SPIN(cond, bar) do { unsigned _sp = 0; while (cond) { __builtin_amdgcn_s_sleep(1); \
    if ((++_sp & 255u) == 0u) { if (xb_ld(&(bar)[XB_TMO])) break; if (_sp > XB_SPIN_CAP) { atomicAdd(&(bar)[XB_TMO], 1u); break; } } } } while (0)

struct XcdBarrier {
    unsigned* bar; unsigned x;
    volatile LAS unsigned* st;
};

__device__ __forceinline__ XcdBarrier xcd_barrier_post(unsigned* bar, volatile LAS unsigned* st) {
    XcdBarrier b; b.bar = bar; b.x = xb_xcc_id(); b.st = st;
    if (threadIdx.x == 0) (void)xb_add(&bar[XB_XCNT(b.x)], 1u);
    return b;
}
__device__ __forceinline__ void xcd_barrier_complete(unsigned* bar, unsigned x, unsigned& nloc, unsigned& nx) {
    const unsigned G = gridDim.x * gridDim.y * gridDim.z;
    unsigned sum, cnt, mine, sp = 0u;
    for (;;) {
        sum = 0u; cnt = 0u; mine = 0u;
#pragma unroll
        for (unsigned j = 0; j < 16; ++j) { const unsigned c = xb_ld(&bar[XB_XCNT(j)]); sum += c; cnt += (c > 0u) ? 1u : 0u; mine = (j == x) ? c : mine; }
        if (sum == G) break;
        __builtin_amdgcn_s_sleep(1);
        if ((++sp & 255u) == 0u) { if (xb_ld(&bar[XB_TMO])) break; if (sp > XB_SPIN_CAP) { atomicAdd(&bar[XB_TMO], 1u); break; } }
    }
    nloc = mine > 0u ? mine : 1u; nx = cnt > 0u ? cnt : 1u;
}

__device__ __forceinline__ void xcd_barrier(const XcdBarrier& b) {
    asm volatile("s_waitcnt vmcnt(0)" ::: "memory");
    __syncthreads();
    if (threadIdx.x == 0) {
        unsigned* bar = b.bar;
        __builtin_amdgcn_s_waitcnt(0);
        unsigned nloc = b.st[0], nx = b.st[1];
        if (nloc == 0u) { xcd_barrier_complete(bar, b.x, nloc, nx); b.st[0] = nloc; b.st[1] = nx; }
        const unsigned old = xb_add(&bar[XB_XSUB(b.x)], 1u);
        const unsigned gen = old / nloc;
        if (old + 1u == (gen + 1u) * nloc) {
            __builtin_amdgcn_fence(__ATOMIC_RELEASE, "agent");
            asm volatile("s_waitcnt vmcnt(0)" ::: "memory");
            const unsigned og = xb_add(&bar[XB_TOP], 1u);
            const unsigned tg = og / nx;
            if (og + 1u == (tg + 1u) * nx) xb_add(&bar[XB_TOPGEN], 1u);
            else XB_SPIN(xb_ld(&bar[XB_TOPGEN]) == tg, bar);
            __builtin_amdgcn_fence(__ATOMIC_ACQUIRE, "agent");
            xb_add(&bar[XB_XGEN(b.x)], 1u);
            asm volatile("s_waitcnt vmcnt(0)" ::: "memory");
        } else {
            XB_SPIN(xb_ld(&bar[XB_XGEN(b.x)]) == gen, bar);
            __builtin_amdgcn_fence(__ATOMIC_ACQUIRE, "agent");
            asm volatile("s_waitcnt vmcnt(0)" ::: "memory");
        }
    }
    __syncthreads();
}

constexpr int NPHASES = 2 + 9 * DEPTH;
#define GRID_SYNC() xcd_barrier(bar)
template <int L>
__device__ __forceinline__ void layer_phases(LAS unsigned char* lds, const int W0, const XcdBarrier& bar) {
    constexpr int Mrows = (L == 0) ? MALL : MLAT;
    { const Params& P = *kparams(); unsigned char* ws = P.ws; const unsigned char* wl = ws + WS_W + (size_t)L * SZ_WL;
      EpiU E{(bf16_t*)(ws + WS_BIG), (const float*)(ws + WS_ROPE)}; run_gemm(lds, (const bf16_t*)(ws + WS_A), (const bf16_t*)wl, MALL, DIN, DM, E, W0); }
    GRID_SYNC();
    { const Params& P = *kparams(); phase_m1(P, lds, L, W0); }
#if DBG_DUPK & 2
    GRID_SYNC(); { const Params& P = *kparams(); phase_m1(P, lds, L, W0); }
#endif
    GRID_SYNC();
    { const Params& P = *kparams(); phase_m2(P, lds, L, 0, W0); }
#if DBG_DUPK & 4
    GRID_SYNC(); { const Params& P = *kparams(); phase_m2(P, lds, L, 1, W0); }
#endif
    GRID_SYNC();
    { const Params& P = *kparams(); phase_m3(P, lds, L, W0); }
#if DBG_DUPK & 8
    GRID_SYNC(); { const Params& P = *kparams(); phase_m3(P, lds, L, W0); }
#endif
    GRID_SYNC();
    { const Params& P = *kparams(); unsigned char* ws = P.ws; const unsigned char* wl = ws + WS_W + (size_t)L * SZ_WL;
      EpiPlain E{(bf16_t*)(ws + WS_BIG), DM, 0}; run_gemm(lds, (const bf16_t*)(ws + WS_MIX), (const bf16_t*)(wl + SZ_WIN), MLAT, DM, KOUT, E, W0);
      if (L == 0) { EpiPlain E2{(bf16_t*)(ws + WS_R2), DM, (size_t)512 * DM}; run_gemm_split(lds, (const bf16_t*)(ws + WS_MIX) + (size_t)MLAT * KOUT, (const bf16_t*)(wl + SZ_WIN), 512, DM, KOUT, 5, E2, W0); } }
    GRID_SYNC();
    { const Params& P = *kparams(); phase_rows(P, lds, 1, L, W0); }
    GRID_SYNC();
    { const Params& P = *kparams(); unsigned char* ws = P.ws; const unsigned char* wl = ws + WS_W + (size_t)L * SZ_WL;
      EpiSwiGLU E{(bf16_t*)(ws + WS_BIG), DFF}; run_gemm(lds, (const bf16_t*)(ws + WS_A), (const bf16_t*)(wl + SZ_WIN + SZ_WOUT), Mrows, 2 * DFF, DM, E, W0); }
    GRID_SYNC();
    { const Params& P = *kparams(); unsigned char* ws = P.ws; const unsigned char* wl = ws + WS_W + (size_t)L * SZ_WL;
      EpiPlain E{(bf16_t*)(ws + WS_R2), DM, 0}; run_gemm(lds, (const bf16_t*)(ws + WS_BIG), (const bf16_t*)(wl + SZ_WIN + SZ_WOUT + SZ_WFI), MLAT, DM, DFF, E, W0);
      if (L == 0) { EpiPlain E2{(bf16_t*)(ws + WS_MIX), DM, (size_t)512 * DM}; run_gemm_split(lds, (const bf16_t*)(ws + WS_BIG) + (size_t)MLAT * DFF, (const bf16_t*)(wl + SZ_WIN + SZ_WOUT + SZ_WFI), 512, DM, DFF, 11, E2, W0); } }
    GRID_SYNC();
    { const Params& P = *kparams(); phase_rows(P, lds, 2, L, W0); }
}

__global__ void __launch_bounds__(NTHREADS, 2) mega_fwd(Params P) {
    extern __shared__ __attribute__((aligned(16))) unsigned char smem[];
    LAS unsigned char* lds = (LAS unsigned char*)smem;
    const int W0 = __builtin_amdgcn_readfirstlane((int)threadIdx.x >> 6);
    volatile LAS unsigned* st = (volatile LAS unsigned*)(lds + LDS_BYTES - 64);
    if (threadIdx.x == 0) { st[0] = 0u; st[1] = 0u; }
    __syncthreads();
    const XcdBarrier bar = xcd_barrier_post((unsigned*)(P.ws + WS_CTL), st);
    phase0(P, lds, W0);
#if DBG_DUPK & 1
    GRID_SYNC(); phase0(P, lds, W0);
#endif
    __syncthreads(); cg::this_grid().sync();
    phase_rows(P, lds, 0, 0, W0);
#if DBG_DUPK & 16
    GRID_SYNC(); phase_rows(P, lds, 0, 0, W0);
#endif
    GRID_SYNC();
    layer_phases<0>(lds, W0, bar);
    GRID_SYNC();
    layer_phases<1>(lds, W0, bar);
}

#if DBG_NAIVE & 2
__global__ void __launch_bounds__(64) dbg_hgrn_naive(Params P, int l, int dir) {
    const int lane = threadIdx.x, b = blockIdx.x >> 2, h = blockIdx.x & 3;
    const bf16_t* U = (const bf16_t*)(P.ws + WS_BIG); bf16_t* MIX = (bf16_t*)(P.ws + WS_MIX);
    float* OF = (float*)(P.ws + WS_A + 16777216);
    const float lb = hgrn_lb(P, l, dir, h * 64 + lane);
    const int fcol = (dir == 0 ? C_FF : C_FB) + h * 64 + lane;
    float S[64];
#pragma unroll
    for (int j = 0; j < 64; ++j) S[j] = 0.f;
    for (int step = 0; step < NCTX + NSEQ; ++step) {
        int row; if (step < NCTX) row = MLAT + b * NCTX + (dir == 0 ? step : NCTX - 1 - step); else { const int s2 = step - NCTX; row = b * NSEQ + (dir == 0 ? s2 : NSEQ - 1 - s2); }
        const bf16_t* ur = U + (size_t)row * DIN;
        const float f = lb + (1.f - lb) * sigmoidf_(bf2f(ur[fcol])); const float q = siluf(bf2f(ur[C_QD + h * 64 + lane])); const float v = bf2f(ur[C_IV + h * 64 + lane]);
        float o = 0.f;
#pragma unroll
        for (int j = 0; j < 64; ++j) { const float fj = __shfl(f, j), qj = __shfl(q, j); S[j] = fj * (S[j] - v) + v; o += S[j] * qj; }
        float* op = OF + (size_t)row * 256 + h * 64 + lane;
        if (dir == 0) *op = o;
        else { const float val = *op + o; const float rstd = rsqrtf(wave_sum(val * val) * (1.f / 64.f) + EPS);
            const float gn = P.in[16][l * 256 + h * 64 + lane]; const float gz = bf2f(ur[C_GD + h * 64 + lane]);
            MIX[(size_t)row * KOUT + O_D + h * 64 + lane] = (bf16_t)f2bf(val * rstd * gn * siluf(gz)); }
    }
}
#endif

#if DBG_NAIVE & 56
__global__ void __launch_bounds__(256) dbg_gemm(const bf16_t* A, int K, const float* W, int ldw, int N, int emode, bf16_t* O, int ldo) {
    const int n = blockIdx.x * 256 + threadIdx.x, row0 = blockIdx.y * 16;
    float acc[16], acc2[16];
#pragma unroll
    for (int r = 0; r < 16; ++r) { acc[r] = 0.f; acc2[r] = 0.f; }
    for (int k8 = 0; k8 < K; k8 += 8) {
        float w[8], w2[8];
#pragma unroll
        for (int i = 0; i < 8; ++i) { w[i] = W[(size_t)(k8 + i) * ldw + n]; w2[i] = emode == 1 ? W[(size_t)(k8 + i) * ldw + N + n] : 0.f; }
#pragma unroll
        for (int r = 0; r < 16; ++r) { const bf16x8 a = *(const bf16x8*)(A + (size_t)(row0 + r) * K + k8);
#pragma unroll
            for (int i = 0; i < 8; ++i) { const float av = bf2f((unsigned short)a[i]); acc[r] += av * w[i]; if (emode == 1) acc2[r] += av * w2[i]; } }
    }
#pragma unroll
    for (int r = 0; r < 16; ++r) { const float v = emode == 1 ? siluf(acc[r]) * acc2[r] : acc[r]; O[(size_t)(row0 + r) * ldo + n] = (bf16_t)f2bf(v); }
}
#endif

#if DBG_NAIVE & 32
__global__ void dbg_fcs(const bf16_t* MIX, bf16_t* F, int M) {
    const int row = blockIdx.x, gm = threadIdx.x, g = gm >> 6, m = gm & 63; if (row >= M) return;
    float s = 0.f;
    for (int j = 0; j < 64; ++j) { float sn, cs; sincospif((float)((m * j) & 63) * (1.f / 32.f), &sn, &cs);
        s += bf2f(MIX[(size_t)row * KOUT + O_Z + g * 64 + j]) * cs + bf2f(MIX[(size_t)row * KOUT + O_Z + 256 + g * 64 + j]) * sn; }
    F[(size_t)row * 256 + gm] = (bf16_t)f2bf(s * 0.125f);
}
__global__ void dbg_cc(const bf16_t* MIX, bf16_t* CC, int M) {
    const int row = blockIdx.x, c = threadIdx.x; if (row >= M) return;
    CC[(size_t)row * 1024 + c] = MIX[(size_t)row * KOUT + O_A + c]; CC[(size_t)row * 1024 + 512 + c] = MIX[(size_t)row * KOUT + O_C + c]; CC[(size_t)row * 1024 + 768 + c] = MIX[(size_t)row * KOUT + O_D + c];
}
#endif
#ifdef DBG_STOP
__global__ void dbg_dump(float* out, const unsigned short* ws16, int n) {
    for (int i = blockIdx.x * blockDim.x + threadIdx.x; i < n; i += gridDim.x * blockDim.x) {
        const unsigned ob = __builtin_bit_cast(unsigned, out[i]); float s = (float)(ob >> 16) + (float)(ob & 0xffffu);
        for (int c = 0; c < 8; ++c) { const size_t idx = (size_t)i + (size_t)c * n; if (idx < WS_END / 2) s += (float)ws16[idx]; }
        out[i] = s; }
}
#endif
extern "C" void kernel_launch(void* const* d_in, const int* in_sizes, int n_in, void* d_out, int out_size, void* d_ws, size_t ws_size, hipStream_t stream) {
    static int grid = 0;
    if (grid == 0) {
        if (n_in != 19 || ws_size < WS_END) { fprintf(stderr, "kernel_launch: unexpected inputs (n_in %d, ws %zu, need %zu)\n", n_in, ws_size, (size_t)WS_END); grid = -1; return; }
        if (hipFuncSetAttribute((const void*)mega_fwd, hipFuncAttributeMaxDynamicSharedMemorySize, LDS_BYTES) != hipSuccess) { fprintf(stderr, "kernel_launch: hipFuncSetAttribute failed\n"); grid = -1; return; }
        int dev = 0, cus = 0, per_cu = 0;
        hipGetDevice(&dev); hipDeviceGetAttribute(&cus, hipDeviceAttributeMultiprocessorCount, dev);
        hipOccupancyMaxActiveBlocksPerMultiprocessor(&per_cu, (const void*)mega_fwd, NTHREADS, LDS_BYTES);
        if (per_cu < 1) { fprintf(stderr, "kernel_launch: occupancy query says %d blocks per CU\n", per_cu); per_cu = 1; }
        (void)hipGetLastError();
        grid = cus * per_cu;
        if (grid != 256) { fprintf(stderr, "kernel_launch: this kernel's phase programs are dealt for exactly 256 co-resident workgroups (256 CUs x 1); got %d; nothing launched\n", grid); grid = -1; return; }
    }
    if (grid < 0) return;
#ifdef DBG_MEMSET
    (void)hipMemsetAsync(d_ws, 0, WS_END, stream);
#endif
    if (hipMemsetAsync((char*)d_ws + WS_CTL, 0, CTL_BYTES, stream) != hipSuccess) { fprintf(stderr, "kernel_launch: memset of barrier words failed\n"); return; }
    Params p{};
    for (int i = 0; i < 19; ++i) p.in[i] = (const float*)d_in[i];
    p.out = (float*)d_out; p.ws = (unsigned char*)d_ws;
    p.ph_lo = 0; p.ph_hi = NPHASES;
    void* args[] = {&p};
    hipError_t e = hipLaunchCooperativeKernel((const void*)mega_fwd, dim3(grid), dim3(NTHREADS), args, LDS_BYTES, stream);
    if (e != hipSuccess) fprintf(stderr, "cooperative launch failed: %s (grid %d)\n", hipGetErrorString(e), grid);
}
```

```cpp
#include <hip/hip_runtime.h>
#include <hip/hip_cooperative_groups.h>
#include <cstdio>
#include <cstdint>
namespace cg = cooperative_groups;

#ifndef MK_SINGLE
#define MK_SINGLE 0
#ifndef DBG_ZERO
#define DBG_ZERO 0
#endif
#ifndef DBG_NPH
#define DBG_NPH 0
#endif
#ifndef DBG_ROWSEL
#define DBG_ROWSEL 0
#endif
#ifndef DBG_NAIVE
#define DBG_NAIVE 0
#endif
#ifndef DBG_DUP
#define DBG_DUP 0
#endif
#ifndef DBG_DUP2
#define DBG_DUP2 0
#endif
#ifndef DBG_DUPK
#define DBG_DUPK 0
#endif
#ifndef HG_BAR
#define HG_BAR 3
#endif
#ifndef DBG_SUB
#define DBG_SUB 15
#endif
#endif

__device__ __forceinline__ int opaque_tid(int w0) { int t; asm volatile("v_mbcnt_lo_u32_b32 %0, -1, 0\n\tv_mbcnt_hi_u32_b32 %0, -1, %0" : "=v"(t)); return w0 * 64 + t; }

namespace pg8 {
#define PG8_LAS __attribute__((address_space(3)))
typedef unsigned short bf16_t;
typedef short bf16x8 __attribute__((ext_vector_type(8)));
typedef float f32x4 __attribute__((ext_vector_type(4)));
typedef unsigned u32x4 __attribute__((ext_vector_type(4)));
constexpr int BM = 256, BK = 64, HALF = 128, HTB = HALF * BK * 2  , STAGE_BYTES = 8 * HTB, NXCD = 8, WGM = 8;

__host__ __device__ __forceinline__ int lds_byte(int r, int c) { const int st = (r >> 4) * 2 + (c >> 5), rr = r & 15, cc = c & 31, ob = rr * 64 + cc * 2; return st * 1024 + (ob ^ (((ob >> 9) & 1) << 5)); }
__host__ __device__ __forceinline__ void stage_rc(int b, int& R, int& C) { const int st = b / 1024, sb = b % 1024, swz = sb ^ (((sb >> 9) & 1) << 5); R = (st >> 1) * 16 + swz / 64; C = (st & 1) * 32 + (swz % 64) / 2; }
__host__ __device__ __forceinline__ int perm32(int rho) { const int n = rho >> 4, i = rho & 15; return 8 * (i >> 2) + 4 * n + (i & 3); }

struct Unit { int pm, pn, ks; };
struct Gemm { const bf16_t* A; const bf16_t* Bt; int M, N, K, ldk; };

struct StaticOrder {
    int nM, nN, nwg, G, c;
    __host__ __device__ void init(int M, int N, int G_, int c_) { nM = M / BM; nN = N / BM; nwg = nM * nN; G = G_; c = c_; }
    __host__ __device__ bool next(int i, Unit& u) const {
        const long L = (long)i * G + c; if (L >= nwg) return false;
        int wgid = (int)L; { const int q = nwg / NXCD, r = nwg % NXCD, xcd = wgid % NXCD, off = wgid / NXCD; wgid = (xcd < r ? xcd * (q + 1) : r * (q + 1) + (xcd - r) * q) + off; }
        const int nig = WGM * nN, gid = wgid / nig, fm = gid * WGM, gsz = (nM - fm) < WGM ? (nM - fm) : WGM;
        u.pm = fm + ((wgid % nig) % gsz); u.pn = (wgid % nig) / gsz; u.ks = 0; return true;
    }
    __device__ __forceinline__ void a_ready(const Unit&) const {}
    __device__ __forceinline__ void done(const Unit&) const {}
};

__device__ __forceinline__ unsigned cvt_pk_bf16(float lo, float hi) { unsigned r; asm volatile("v_cvt_pk_bf16_f32 %0, %1, %2" : "=v"(r) : "v"(lo), "v"(hi)); return r; }
template <class Epi, class Sched, bool ALIGN_EPI = false, bool SP2 = false>
__device__ __forceinline__ void gemm_phase(PG8_LAS unsigned char* lds, const Gemm g, const Sched& S, const Epi& E, const int W0) {
    const int tid = opaque_tid(W0), wid = __builtin_amdgcn_readfirstlane(tid >> 6), lane = tid & 63, wr = wid >> 2, wc = wid & 3, fr = lane & 15, fq = lane >> 4;
    const int K = g.ldk, nt = g.K / BK;
    const size_t sstep = (size_t)g.K * 2;
    unsigned voffA[2], voffB[2];
#pragma unroll
    for (int i = 0; i < 2; ++i) { int R, C; stage_rc(tid * 16 + i * 8192, R, C); const int Rb = Epi::PERM ? ((R & ~31) + perm32(R & 31)) : R;
        voffA[i] = (unsigned)(R * K + C) * 2u; voffB[i] = (unsigned)(Rb * K + C) * 2u; }
    const size_t kstep = (size_t)(BK * 2);
    const size_t hstep = (size_t)HALF * K * 2;
    const size_t tstep = 2 * hstep;
    const unsigned ldsw = (unsigned)wid * 1024u;
    const int aoff = lds_byte(wr * 64 + fr, fq * 8), boff = lds_byte(wc * 32 + fr, fq * 8);
#define PG8_SA(b, h) (((b) * 2 + (h)) * HTB)
#define PG8_SB(b, h) ((4 + (b) * 2 + (h)) * HTB)
#define PG8_STAGE(bufoff, gbase, voff) do { _Pragma("unroll") for (int _i = 0; _i < 2; ++_i) \
        __builtin_amdgcn_global_load_lds((const unsigned*)((const char*)(gbase) + (voff)[_i]), (PG8_LAS unsigned*)(lds + (bufoff) + ldsw + _i * 8192), 16, 0, 0); } while (0)
#define PG8_LDA(dst, b, h) do { _Pragma("unroll") for (int m = 0; m < 4; ++m) _Pragma("unroll") for (int k = 0; k < 2; ++k) dst[m][k] = *(const PG8_LAS bf16x8*)(lds + PG8_SA(b, h) + aoff + m * 2048 + k * 1024); } while (0)
#define PG8_LDB(dst, b, h) do { _Pragma("unroll") for (int n = 0; n < 2; ++n) _Pragma("unroll") for (int k = 0; k < 2; ++k) dst[n][k] = *(const PG8_LAS bf16x8*)(lds + PG8_SB(b, h) + boff + n * 2048 + k * 1024); } while (0)
#define PG8_MMA(ai, bj, At, Bt) do { __builtin_amdgcn_s_setprio(1); _Pragma("unroll") for (int m = 0; m < 4; ++m) _Pragma("unroll") for (int n = 0; n < 2; ++n) _Pragma("unroll") for (int k = 0; k < 2; ++k) \
        acc[ai][bj][m][n] = __builtin_amdgcn_mfma_f32_16x16x32_bf16(Bt[n][k], At[m][k], acc[ai][bj][m][n], 0, 0, 0); __builtin_amdgcn_s_setprio(0); } while (0)
#define PG8_WAIT_V(n) asm volatile("s_waitcnt vmcnt(" #n ")" ::: "memory")
#define PG8_WAIT_L(n) asm volatile("s_waitcnt lgkmcnt(" #n ")" ::: "memory")
#define PG8_BAR __builtin_amdgcn_s_barrier()
#define PG8_SCHED __builtin_amdgcn_sched_barrier(0)
    Unit cur, nxt; int ui = 0;
    if (!S.next(0, cur)) return;
    f32x4 acc[2][2][4][2];
#pragma unroll
    for (int a = 0; a < 2; ++a)
#pragma unroll
        for (int b = 0; b < 2; ++b)
#pragma unroll
            for (int m = 0; m < 4; ++m)
#pragma unroll
                for (int n = 0; n < 2; ++n) acc[a][b][m][n] = (f32x4){0.f, 0.f, 0.f, 0.f};
    bf16x8 At[4][2], B0[2][2], B1[2][2];
    const char* cA = (const char*)g.A + (size_t)cur.pm * tstep + (size_t)cur.ks * sstep; const char* cB = (const char*)g.Bt + (size_t)cur.pn * tstep + (size_t)cur.ks * sstep;
    S.a_ready(cur);
    if constexpr (SP2) {
        PG8_STAGE(PG8_SB(0, 0), cB, voffB); PG8_STAGE(PG8_SB(0, 1), cB + hstep, voffB); PG8_STAGE(PG8_SA(0, 0), cA, voffA); PG8_STAGE(PG8_SA(0, 1), cA + hstep, voffA);
        if (wr == 1) PG8_BAR;
        PG8_WAIT_V(2); PG8_BAR;
        PG8_STAGE(PG8_SB(1, 0), cB + kstep, voffB); PG8_STAGE(PG8_SA(1, 0), cA + kstep, voffA); PG8_STAGE(PG8_SB(1, 1), cB + hstep + kstep, voffB);
        PG8_WAIT_V(6); PG8_BAR;
    } else {
        PG8_STAGE(PG8_SB(0, 0), cB, voffB); PG8_STAGE(PG8_SA(0, 0), cA, voffA); PG8_STAGE(PG8_SB(0, 1), cB + hstep, voffB); PG8_STAGE(PG8_SA(0, 1), cA + hstep, voffA);
        if (wr == 1) PG8_BAR;
        PG8_WAIT_V(4); PG8_BAR;
        PG8_STAGE(PG8_SB(1, 0), cB + kstep, voffB); PG8_STAGE(PG8_SA(1, 0), cA + kstep, voffA); PG8_STAGE(PG8_SB(1, 1), cB + hstep + kstep, voffB);
        PG8_WAIT_V(6); PG8_BAR;
    }
    for (;;) {
        const bool has_next = S.next(ui + 1, nxt);
        const char* nA = has_next ? (const char*)g.A + (size_t)nxt.pm * tstep + (size_t)nxt.ks * sstep : cA; const char* nB = has_next ? (const char*)g.Bt + (size_t)nxt.pn * tstep + (size_t)nxt.ks * sstep : cB;
        for (int t = 0; t < nt; t += 2) {
            const bool last = (t == nt - 2);
            const char* a1 = cA + (size_t)(t + 1) * kstep;
            const char* a2 = last ? nA : cA + (size_t)(t + 2) * kstep; const char* b2 = last ? nB : cB + (size_t)(t + 2) * kstep;
            const char* a3 = a2 + kstep; const char* b3 = b2 + kstep;
            if (last && has_next) S.a_ready(nxt);
            if constexpr (SP2) {
            PG8_LDB(B0, 0, 0); PG8_LDB(B1, 0, 1); PG8_SCHED; PG8_LDA(At, 0, 0); PG8_STAGE(PG8_SA(1, 1), a1 + hstep, voffA);
            PG8_WAIT_V(8); PG8_WAIT_L(0); PG8_BAR; PG8_MMA(0, 0, At, B0); PG8_MMA(0, 1, At, B1); PG8_BAR; PG8_SCHED;
            PG8_LDA(At, 0, 1); PG8_STAGE(PG8_SB(0, 0), b2, voffB); PG8_STAGE(PG8_SB(0, 1), b2 + hstep, voffB); PG8_STAGE(PG8_SA(0, 0), a2, voffA);
            PG8_WAIT_V(8); PG8_WAIT_L(0); PG8_BAR; PG8_MMA(1, 0, At, B0); PG8_MMA(1, 1, At, B1); PG8_BAR; PG8_SCHED;
            PG8_LDB(B0, 1, 0); PG8_LDB(B1, 1, 1); PG8_SCHED; PG8_LDA(At, 1, 0); PG8_STAGE(PG8_SA(0, 1), a2 + hstep, voffA);
            PG8_WAIT_V(8); PG8_WAIT_L(0); PG8_BAR; PG8_MMA(0, 0, At, B0); PG8_MMA(0, 1, At, B1); PG8_BAR; PG8_SCHED;
            PG8_LDA(At, 1, 1); PG8_STAGE(PG8_SB(1, 0), b3, voffB); PG8_STAGE(PG8_SB(1, 1), b3 + hstep, voffB); PG8_STAGE(PG8_SA(1, 0), a3, voffA);
            PG8_WAIT_V(8); PG8_WAIT_L(0); PG8_BAR; PG8_MMA(1, 0, At, B0); PG8_MMA(1, 1, At, B1); PG8_BAR; PG8_SCHED;
            } else {
            PG8_LDB(B0, 0, 0); PG8_SCHED; PG8_LDA(At, 0, 0); PG8_STAGE(PG8_SA(1, 1), a1 + hstep, voffA);
            PG8_WAIT_L(8); PG8_BAR; PG8_WAIT_L(0); PG8_MMA(0, 0, At, B0); PG8_BAR; PG8_SCHED;
            PG8_LDB(B1, 0, 1); PG8_STAGE(PG8_SB(0, 0), b2, voffB);
            PG8_BAR; PG8_WAIT_L(0); PG8_MMA(0, 1, At, B1); PG8_BAR;
            PG8_LDA(At, 0, 1); PG8_STAGE(PG8_SA(0, 0), a2, voffA);
            PG8_BAR; PG8_WAIT_L(0); PG8_MMA(1, 0, At, B0); PG8_BAR; PG8_SCHED;
            PG8_STAGE(PG8_SB(0, 1), b2 + hstep, voffB);
            PG8_WAIT_V(6); PG8_BAR; PG8_MMA(1, 1, At, B1); PG8_BAR;
            PG8_LDB(B0, 1, 0); PG8_SCHED; PG8_LDA(At, 1, 0); PG8_STAGE(PG8_SA(0, 1), a2 + hstep, voffA);
            PG8_WAIT_L(8); PG8_BAR; PG8_WAIT_L(0); PG8_MMA(0, 0, At, B0); PG8_BAR; PG8_SCHED;
            PG8_LDB(B1, 1, 1); PG8_STAGE(PG8_SB(1, 0), b3, voffB);
            PG8_BAR; PG8_WAIT_L(0); PG8_MMA(0, 1, At, B1); PG8_BAR;
            PG8_LDA(At, 1, 1); PG8_STAGE(PG8_SA(1, 0), a3, voffA);
            PG8_BAR; PG8_WAIT_L(0); PG8_MMA(1, 0, At, B0); PG8_BAR; PG8_SCHED;
            PG8_STAGE(PG8_SB(1, 1), b3 + hstep, voffB);
            PG8_WAIT_V(6); PG8_BAR; PG8_MMA(1, 1, At, B1); PG8_BAR;
            }
        }
        if constexpr (ALIGN_EPI) { if (wr == 0) PG8_BAR; }
        if constexpr (!Epi::AFTER_DRAIN) { E(acc, cur, wr, wc, fr, fq); S.done(cur); }
        if (!has_next) break;
#pragma unroll
        for (int a = 0; a < 2; ++a)
#pragma unroll
            for (int b = 0; b < 2; ++b)
#pragma unroll
                for (int m = 0; m < 4; ++m)
#pragma unroll
                    for (int n = 0; n < 2; ++n) acc[a][b][m][n] = (f32x4){0.f, 0.f, 0.f, 0.f};
        cur = nxt; cA = nA; cB = nB; ++ui;
        if constexpr (ALIGN_EPI) { if (wr == 1) PG8_BAR; }
    }
    PG8_WAIT_V(0);
    if constexpr (!ALIGN_EPI) { if (wr == 0) PG8_BAR; }
    PG8_BAR;
    if constexpr (Epi::AFTER_DRAIN) { E.fused(acc, cur, wr, wc, fr, fq, lds, wid, lane); S.done(cur); }
#undef PG8_SA
#undef PG8_SB
#undef PG8_STAGE
#undef PG8_LDA
#undef PG8_LDB
#undef PG8_MMA
#undef PG8_WAIT_V
#undef PG8_WAIT_L
#undef PG8_BAR
#undef PG8_SCHED
}
}

namespace pg8 {
struct SplitOrder {
    int nN, S, nwg, G, c;
    __host__ __device__ void init(int M, int N, int S_, int G_, int c_) { nN = N / BM; S = S_; nwg = (M / BM) * nN * S; G = G_; c = c_; }
    __host__ __device__ bool next(int i, Unit& u) const { const long L = (long)i * G + c; if (L >= nwg) return false; const int l = (int)L; u.ks = l % S; u.pn = (l / S) % nN; u.pm = l / (S * nN); return true; }
    __device__ __forceinline__ void a_ready(const Unit&) const {}
    __device__ __forceinline__ void done(const Unit&) const {}
};
}
#define LAS __attribute__((address_space(3)))
typedef unsigned short bf16_t;
typedef short bf16x8 __attribute__((ext_vector_type(8)));
typedef float f32x4 __attribute__((ext_vector_type(4)));
typedef unsigned u32x4 __attribute__((ext_vector_type(4)));
typedef unsigned u32x2 __attribute__((ext_vector_type(2)));

constexpr int NBATCH = 2, NSEQ = 8192, DM = 1024, NCTX = 256, DEPTH = 2;
constexpr int MLAT = NBATCH * NSEQ;
constexpr int MALL = MLAT + NBATCH * NCTX;
constexpr int DIN = 2816, DFF = 2816, KOUT = 1280;
constexpr float EPS = 1e-6f;
constexpr int C_QA = 0, C_KA = 256, C_VA = 512, C_UB = 768, C_QS = 1024, C_KS = 1280, C_VS = 1408, C_QD = 1536, C_FF = 1792, C_FB = 2048, C_IV = 2304, C_GD = 2560;
constexpr int O_A = 0, O_C = 256, O_D = 512, O_Z = 768;
constexpr int NCHUNK = 132;

constexpr size_t SZ_WIN = (size_t)DIN * DM * 2, SZ_WOUT = (size_t)DM * KOUT * 2, SZ_WFI = (size_t)2 * DFF * DM * 2, SZ_WFO = (size_t)DM * DFF * 2;
constexpr size_t SZ_WL = SZ_WIN + SZ_WOUT + SZ_WFI + SZ_WFO;
constexpr size_t WS_W = 0;
constexpr size_t WS_A = WS_W + 2 * SZ_WL;
constexpr size_t WS_MIX = WS_A + (size_t)MALL * DM * 2;
constexpr size_t WS_BIG = WS_MIX + (size_t)MALL * KOUT * 2;
constexpr size_t WS_R2 = WS_BIG + (size_t)MALL * DIN * 2;
constexpr size_t WS_MISC = WS_R2 + (size_t)MALL * DM * 2;
constexpr size_t WS_ADAP = WS_MISC;
constexpr size_t WS_HCTX = WS_ADAP + (size_t)2 * 8 * 3 * 6144 * 4;
constexpr size_t WS_HD = WS_HCTX + (size_t)512 * 1024 * 4;
constexpr size_t WS_TA = WS_HD + (size_t)16 * NCHUNK * 64 * 4;
constexpr size_t WS_TC = WS_TA + 128 * 64 * 2;
constexpr size_t WS_TCTX = WS_TC + 256 * 256 * 2;
constexpr size_t WS_ROPE = WS_TCTX + 512 * 256 * 2;
constexpr size_t WS_ADAF = WS_ROPE + 128 * 16 * 8;
constexpr size_t WS_CTL = WS_ADAF + (size_t)2 * 3 * 6144 * 4;
constexpr size_t CTL_BYTES = 16384;
constexpr size_t WS_END = WS_CTL + CTL_BYTES;
static_assert(WS_END <= 268435456, "workspace map exceeds 256 MiB");
static_assert((size_t)16 * NCHUNK * 4096 * 4 <= (size_t)MALL * DM * 2, "HGRN states fit R2");

constexpr int LDS_BYTES = 147456;
constexpr int NTHREADS = 512, NWAVES = 8;

struct Params {
    const float* in[19];
    float* out;
    unsigned char* ws;
    int ph_lo, ph_hi;
};

__device__ __forceinline__ const Params* kparams() {
    unsigned long long p = (unsigned long long)__builtin_amdgcn_kernarg_segment_ptr(); asm volatile("" : "+s"(p)); return (const Params*)(const __attribute__((address_space(4))) void*)p; }
__device__ __forceinline__ unsigned f2bf(float f) { unsigned u = __builtin_bit_cast(unsigned, f); return (u + 0x7fffu + ((u >> 16) & 1u)) >> 16; }
typedef float f32x2_t __attribute__((ext_vector_type(2)));
typedef __bf16 bf16x2_t __attribute__((ext_vector_type(2)));
__device__ __forceinline__ unsigned pk2(float lo, float hi) { f32x2_t v = {lo, hi}; bf16x2_t b = __builtin_convertvector(v, bf16x2_t); return __builtin_bit_cast(unsigned, b); }
__device__ __forceinline__ float bf2f(unsigned short h) { return __builtin_bit_cast(float, (unsigned)h << 16); }
__device__ __forceinline__ float bflo(unsigned w) { return __builtin_bit_cast(float, w << 16); }
__device__ __forceinline__ float bfhi(unsigned w) { return __builtin_bit_cast(float, w & 0xffff0000u); }
__device__ __forceinline__ float wave_sum(float v) {
#pragma unroll
    for (int o = 1; o < 64; o <<= 1) v += __shfl_xor(v, o);
    return v;
}
__device__ __forceinline__ float siluf(float a) { return a / (1.f + __expf(-a)); }
__device__ __forceinline__ float sigmoidf_(float a) { return 1.f / (1.f + __expf(-a)); }

struct EpiPlain {
    static constexpr bool PERM = true, AFTER_DRAIN = false;
    bf16_t* O; int ldc; size_t pstride;
    __device__ __forceinline__ void operator()(const f32x4 (&acc)[2][2][4][2], const pg8::Unit& u, int wr, int wc, int fr, int fq) const {
        const int row0 = u.pm * 256 + wr * 64 + fr, col0 = u.pn * 256 + wc * 32 + 8 * fq;
#pragma unroll
        for (int ai = 0; ai < 2; ++ai)
#pragma unroll
            for (int m = 0; m < 4; ++m) { bf16_t* rowp = O + (size_t)u.ks * pstride + (size_t)(row0 + ai * 128 + m * 16) * ldc + col0;
#pragma unroll
                for (int bj = 0; bj < 2; ++bj) { const f32x4 v0 = acc[ai][bj][m][0], v1 = acc[ai][bj][m][1];
                    u32x4 w; w.x = pk2(v0[0], v0[1]); w.y = pk2(v0[2], v0[3]); w.z = pk2(v1[0], v1[1]); w.w = pk2(v1[2], v1[3]);
                    *(u32x4*)(rowp + bj * 128) = w; } }
    }
};
struct EpiSwiGLU {
    static constexpr bool PERM = true, AFTER_DRAIN = false;
    bf16_t* O; int ldc;
    __device__ __forceinline__ void operator()(const f32x4 (&acc)[2][2][4][2], const pg8::Unit& u, int wr, int wc, int fr, int fq) const {
        const int row0 = u.pm * 256 + wr * 64 + fr, col0 = u.pn * 128 + wc * 32 + 8 * fq;
#pragma unroll
        for (int ai = 0; ai < 2; ++ai)
#pragma unroll
            for (int m = 0; m < 4; ++m) { bf16_t* rowp = O + (size_t)(row0 + ai * 128 + m * 16) * ldc + col0;
                float h[8];
#pragma unroll
                for (int n = 0; n < 2; ++n)
#pragma unroll
                    for (int j = 0; j < 4; ++j) { const float a = acc[ai][0][m][n][j], g = acc[ai][1][m][n][j]; h[n * 4 + j] = a * __builtin_amdgcn_rcpf(1.f + __expf(-a)) * g; }
                u32x4 w; w.x = pk2(h[0], h[1]); w.y = pk2(h[2], h[3]); w.z = pk2(h[4], h[5]); w.w = pk2(h[6], h[7]);
                *(u32x4*)rowp = w; }
    }
};
struct EpiU {
    static constexpr bool PERM = false, AFTER_DRAIN = false;
    bf16_t* O; const float* rope;
    __device__ __forceinline__ void operator()(const f32x4 (&acc)[2][2][4][2], const pg8::Unit& u, int wr, int wc, int fr, int fq) const {
        const int row0 = u.pm * 256 + wr * 64 + fr, col0 = u.pn * 256 + wc * 32 + 4 * fq;
        const bool lat = (u.pm < 64);
#pragma unroll
        for (int ai = 0; ai < 2; ++ai)
#pragma unroll
            for (int m = 0; m < 4; ++m) { const int row = row0 + ai * 128 + m * 16; bf16_t* rowp = O + (size_t)row * DIN + col0;
                const int t = row & (NSEQ - 1); const int pos = (wc & 1) ? (t & 63) : (t >> 6);
                f32x4 cs0 = {1.f, 0.f, 1.f, 0.f}, cs1 = {1.f, 0.f, 1.f, 0.f};
                const bool anyrope = lat && (u.pn == 4 || u.pn == 5);
                if (anyrope) { const f32x4* rp = (const f32x4*)(rope + (size_t)(pos * 16 + 4 * fq) * 2); cs0 = rp[0]; cs1 = rp[1]; }
#pragma unroll
                for (int bj = 0; bj < 2; ++bj) { f32x4 v0 = acc[ai][bj][m][0], v1 = acc[ai][bj][m][1];
                    if (anyrope && (u.pn == 4 || bj == 0)) {
                        const float c[4] = {cs0[0], cs0[2], cs1[0], cs1[2]}, s[4] = {cs0[1], cs0[3], cs1[1], cs1[3]};
#pragma unroll
                        for (int j = 0; j < 4; ++j) { const float x1 = v0[j], x2 = v1[j]; v0[j] = x1 * c[j] - x2 * s[j]; v1[j] = x1 * s[j] + x2 * c[j]; }
                    }
                    u32x2 w0, w1; w0.x = pk2(v0[0], v0[1]); w0.y = pk2(v0[2], v0[3]); w1.x = pk2(v1[0], v1[1]); w1.y = pk2(v1[2], v1[3]);
                    *(u32x2*)(rowp + bj * 128) = w0; *(u32x2*)(rowp + bj * 128 + 16) = w1; } }
    }
};

__device__ __forceinline__ void transpose_tile(const float* W, int N, int k0s, int n0s, bf16_t* WT, int ldk, int n0d, int k0d, LAS float* scr, int tid) {
    { const int kk = tid >> 3, c8 = (tid & 7) * 8; const float* src = W + (size_t)(k0s + kk) * N + n0s + c8;
      const f32x4 a = *(const f32x4*)src, b = *(const f32x4*)(src + 4);
#pragma unroll
      for (int e = 0; e < 4; ++e) { scr[(c8 + e) * 65 + kk] = a[e]; scr[(c8 + 4 + e) * 65 + kk] = b[e]; } }
    __syncthreads();
    { const int nn = tid >> 3, k8 = (tid & 7) * 8; const LAS float* s = scr + nn * 65 + k8;
      u32x4 o; o.x = pk2(s[0], s[1]); o.y = pk2(s[2], s[3]); o.z = pk2(s[4], s[5]); o.w = pk2(s[6], s[7]);
      *(u32x4*)(WT + (size_t)(n0d + nn) * ldk + k0d + k8) = o; }
    __syncthreads();
}

__device__ __forceinline__ void phase0(const Params& P_, LAS unsigned char* lds, int W0) {
    const Params& P = *kparams();
    const int tid = opaque_tid(W0), G = gridDim.x, bid = blockIdx.x;
    unsigned char* ws = P.ws;
    LAS float* scr = (LAS float*)lds;
    constexpr int T_IN = 16 * 44, T_OUT = 12 * 16, T_FI = 16 * 88, T_FO = 44 * 16, T_L = T_IN + T_OUT + T_FI + T_FO;
    constexpr int N_TR = 2 * T_L, N_ADA = 2 * 24 * 8, N_M2 = 2 * 4 * 16, N_TAB = 64;
    constexpr int N_ALL = N_TR + N_ADA + N_M2 + N_TAB;
    for (int it = bid; it < N_ALL; it += G) {
        if (it < N_TR) {
            const int l = it / T_L; int r = it % T_L;
            bf16_t* wl = (bf16_t*)(ws + WS_W + (size_t)l * SZ_WL);
            if (r < T_IN) { const int kt = r / 44, nt = r % 44; transpose_tile(P.in[10] + (size_t)l * DM * DIN, DIN, kt * 64, nt * 64, wl, DM, nt * 64, kt * 64, scr, tid); continue; } r -= T_IN;
            if (r < T_OUT) { const int ktd = r / 16, nt = r % 16; const int kts = ktd < 4 ? ktd : ktd + 4;
                transpose_tile(P.in[11] + (size_t)l * DM * DM, DM, kts * 64, nt * 64, (bf16_t*)((unsigned char*)wl + SZ_WIN), KOUT, nt * 64, ktd * 64, scr, tid); continue; } r -= T_OUT;
            if (r < T_FI) { const int kt = r / 88, ntd = r % 88; const int pn = ntd >> 2, bj = (ntd >> 1) & 1, hf = ntd & 1; const int n0s = bj * DFF + pn * 128 + hf * 64;
                transpose_tile(P.in[17] + (size_t)l * DM * 2 * DFF, 2 * DFF, kt * 64, n0s, (bf16_t*)((unsigned char*)wl + SZ_WIN + SZ_WOUT), DM, ntd * 64, kt * 64, scr, tid); continue; } r -= T_FI;
            { const int kt = r / 16, nt = r % 16; transpose_tile(P.in[18] + (size_t)l * DFF * DM, DM, kt * 64, nt * 64, (bf16_t*)((unsigned char*)wl + SZ_WIN + SZ_WOUT + SZ_WFI), DFF, nt * 64, kt * 64, scr, tid); }
            continue;
        }
        int r = it - N_TR;
        if (r < N_ADA) {
            const int l = r / 192, jc = (r % 192) / 8, kc = r % 8;
            LAS float* sv = scr;
            LAS float* red = scr + 384;
            if (tid < 384) { const int v = tid >> 7, k = tid & 127; const float cv = (v < 2) ? P.in[1][v * DM + kc * 128 + k] : P.in[3][kc * 128 + k]; sv[tid] = siluf(cv); }
            __syncthreads();
            const int col = jc * 256 + (tid & 255), kh = tid >> 8;
            const float* w = P.in[4] + (size_t)l * DM * 6144 + (size_t)(kc * 128 + kh * 64) * 6144 + col;
            float a0 = 0.f, a1 = 0.f, a2 = 0.f;
#pragma unroll 8
            for (int k = 0; k < 64; ++k) { const float wv = w[(size_t)k * 6144]; a0 += sv[kh * 64 + k] * wv; a1 += sv[128 + kh * 64 + k] * wv; a2 += sv[256 + kh * 64 + k] * wv; }
            if (kh == 1) { red[(tid & 255) * 3 + 0] = a0; red[(tid & 255) * 3 + 1] = a1; red[(tid & 255) * 3 + 2] = a2; }
            __syncthreads();
            if (kh == 0) { float* dst = (float*)(ws + WS_ADAP) + (size_t)((l * 8 + kc) * 3) * 6144 + col;
                dst[0] = a0 + red[tid * 3 + 0]; dst[6144] = a1 + red[tid * 3 + 1]; dst[2 * 6144] = a2 + red[tid * 3 + 2]; }
            __syncthreads();
            continue;
        }
        r -= N_ADA;
        if (r < N_M2) {
            const int l = r / 64, g = (r % 64) / 16, nt = r % 16;
            const float* wf = P.in[13] + (size_t)l * 256 * 256 + (size_t)g * 64 * 256;
            const float* wo = P.in[11] + (size_t)l * DM * DM + (size_t)256 * DM + nt * 64;
            LAS float* wfs = scr;
            LAS float* wos = scr + 64 * 132;
            LAS float* Pm = wos + 128 * 64;
            LAS float* cst = Pm + 4096;
            const int n = tid & 63, mg = tid >> 6;
            float acc[8];
#pragma unroll
            for (int i = 0; i < 8; ++i) acc[i] = 0.f;
            for (int h2 = 0; h2 < 2; ++h2) {
#pragma unroll
                for (int k = 0; k < 16; ++k) { const int idx = tid + k * NTHREADS; { const int r_ = idx >> 7, c_ = idx & 127; wfs[r_ * 132 + c_] = wf[(size_t)r_ * 256 + h2 * 128 + c_]; }
                                               { const int r_ = idx >> 6, c_ = idx & 63; wos[r_ * 64 + c_] = wo[(size_t)(h2 * 128 + r_) * DM + c_]; } }
                __syncthreads();
                for (int q = 0; q < 128; q += 4) { const float w0 = wos[(q + 0) * 64 + n], w1 = wos[(q + 1) * 64 + n], w2 = wos[(q + 2) * 64 + n], w3 = wos[(q + 3) * 64 + n];
#pragma unroll
                    for (int i = 0; i < 8; ++i) { const f32x4 f4 = *(const LAS f32x4*)(wfs + (mg * 8 + i) * 132 + q); acc[i] += (f4[0] * w0 + f4[1] * w1) + (f4[2] * w2 + f4[3] * w3); } }
                __syncthreads();
            }
#pragma unroll
            for (int i = 0; i < 8; ++i) Pm[(mg * 8 + i) * 64 + n] = acc[i];
            if (tid < 64) cst[tid] = cospif((float)tid * (1.f / 32.f));
            __syncthreads();
            bf16_t* wot = (bf16_t*)(ws + WS_W + (size_t)l * SZ_WL + SZ_WIN);
            for (int rr = mg; rr < 128; rr += 8) { const int p = rr >> 6, j = rr & 63; float s = 0.f;
                for (int m = 0; m < 64; ++m) { const int a = (m * j) & 63; const float cs = p ? cst[(a + 48) & 63] : cst[a];
                    s += cs * Pm[m * 64 + n]; }
                wot[(size_t)(nt * 64 + n) * KOUT + 768 + p * 256 + g * 64 + j] = (bf16_t)f2bf(s * 0.125f); }
            __syncthreads();
            continue;
        }
        r -= N_M2;
        {
            const int NT = 64 * 512; const int gi = r * 512 + tid;
            bf16_t* TA = (bf16_t*)(ws + WS_TA); bf16_t* TC = (bf16_t*)(ws + WS_TC); bf16_t* TX = (bf16_t*)(ws + WS_TCTX); float* RP = (float*)(ws + WS_ROPE);
            for (int i = gi; i < 128 * 64; i += NT) { const int rr = i >> 6, t = i & 63; const int a = ((rr & 63) * t) & 63; float s, c; sincospif((float)a * (1.f / 32.f), &s, &c); TA[i] = (bf16_t)f2bf(rr < 64 ? c : -s); }
            for (int i = gi; i < 256 * 256; i += NT) { const int rr = i >> 8, cc = i & 255; const int p = rr >> 7, k2 = rr & 127, pp = cc >> 7, t2 = cc & 127; const int a = (k2 * t2) & 127;
                float s, c; sincospif((float)a * (1.f / 64.f), &s, &c); const float sc = 0.011048543456039806f;
                const float v = (p == 0) ? (pp == 0 ? c : s) : (pp == 0 ? -s : c); TC[i] = (bf16_t)f2bf(v * sc); }
            for (int i = gi; i < 512 * 256; i += NT) { const int rr = i >> 8, t = i & 255; const int p = rr >> 8, k = rr & 255; const int a = (k * t) & 255;
                float s, c; sincospif((float)a * (1.f / 128.f), &s, &c); TX[i] = (bf16_t)f2bf((p == 0 ? c : -s) * 0.0625f); }
            for (int i = gi; i < 128 * 16; i += NT) { const int pos = i >> 4, fi = i & 15; const float fr = powf(10000.f, -(float)fi * (1.f / 16.f)); const float ang = (float)pos * fr;
                RP[2 * i] = cosf(ang); RP[2 * i + 1] = sinf(ang); }
        }
    }
}

__device__ __forceinline__ float ada_value(const Params& P, int l, int v, int col) {
    const float* adap = (const float*)(P.ws + WS_ADAP); float s = P.in[5][l * 6144 + col];
#pragma unroll
    for (int kc = 0; kc < 8; ++kc) s += adap[(size_t)((l * 8 + kc) * 3 + v) * 6144 + col];
    return s;
}
template <bool FINAL>
__device__ __forceinline__ void load_mod(LAS float* dst, const Params& P, int l, int kind, int tid) {
    const float* adaf = (const float*)(P.ws + WS_ADAF);
    for (int i = tid; i < 3 * 1024; i += NTHREADS) { const int v = i >> 10, j = i & 1023, col = kind * 1024 + j;
        dst[i] = FINAL ? adaf[(size_t)(l * 3 + v) * 6144 + col] : ada_value(P, l, v, col); }
}
struct RowIn { f32x4 x[4]; u32x2 d[4]; };
__device__ __forceinline__ void row_load(RowIn& r, const float* xin, const bf16_t* delta, int lane) {
#pragma unroll
    for (int i = 0; i < 4; ++i) { r.x[i] = *(const f32x4*)(xin + lane * 4 + 256 * i); r.d[i] = delta ? *(const u32x2*)(delta + lane * 4 + 256 * i) : (u32x2){0u, 0u}; }
}
__device__ __forceinline__ void row_pass(const RowIn& rin, const bf16_t* delta, int npart, size_t pstride, const float* gpost, const LAS float* gt, float* xout,
                                         const float* gpre, const LAS float* sc, const LAS float* sh, bf16_t* aout, int lane) {
    f32x4 x[4];
#pragma unroll
    for (int i = 0; i < 4; ++i) x[i] = rin.x[i];
    if (delta) {
        f32x4 d[4]; float ss = 0.f;
#pragma unroll
        for (int i = 0; i < 4; ++i) { const u32x2 w = rin.d[i]; d[i] = (f32x4){bflo(w.x), bfhi(w.x), bflo(w.y), bfhi(w.y)};
            for (int pp = 1; pp < npart; ++pp) { const u32x2 w2 = *(const u32x2*)(delta + (size_t)pp * pstride + lane * 4 + 256 * i); d[i] = d[i] + (f32x4){bflo(w2.x), bfhi(w2.x), bflo(w2.y), bfhi(w2.y)}; }
            ss += (d[i][0] * d[i][0] + d[i][1] * d[i][1]) + (d[i][2] * d[i][2] + d[i][3] * d[i][3]); }
        const float rstd = rsqrtf(wave_sum(ss) * (1.f / DM) + EPS);
#pragma unroll
        for (int i = 0; i < 4; ++i) { const f32x4 g = *(const f32x4*)(gpost + lane * 4 + 256 * i); const f32x4 t = *(const LAS f32x4*)(gt + lane * 4 + 256 * i);
            x[i] = x[i] + t * (d[i] * rstd * g); }
    }
    if (xout) {
#pragma unroll
        for (int i = 0; i < 4; ++i) *(f32x4*)(xout + lane * 4 + 256 * i) = x[i];
    }
    if (aout) {
        float ss = 0.f;
#pragma unroll
        for (int i = 0; i < 4; ++i) ss += (x[i][0] * x[i][0] + x[i][1] * x[i][1]) + (x[i][2] * x[i][2] + x[i][3] * x[i][3]);
        const float rstd = rsqrtf(wave_sum(ss) * (1.f / DM) + EPS);
#pragma unroll
        for (int i = 0; i < 4; ++i) { const f32x4 g = *(const f32x4*)(gpre + lane * 4 + 256 * i); const f32x4 s1 = *(const LAS f32x4*)(sc + lane * 4 + 256 * i); const f32x4 s0 = *(const LAS f32x4*)(sh + lane * 4 + 256 * i);
            const f32x4 y = (x[i] * rstd * g) * (s1 + 1.f) + s0; u32x2 w; w.x = pk2(y[0], y[1]); w.y = pk2(y[2], y[3]);
            *(u32x2*)(aout + lane * 4 + 256 * i) = w; }
    }
}
__device__ __forceinline__ void phase_rows(const Params& P_, LAS unsigned char* lds, int mode, int l, int W0) {
    const Params& P = *kparams();
    const int tid = opaque_tid(W0), lane = tid & 63, wave = tid >> 6;
    LAS float* m0 = (LAS float*)lds;
    LAS float* m1 = m0 + 3072; LAS float* m2 = m1 + 3072;
    bf16_t* A = (bf16_t*)(P.ws + WS_A);
    float* hctx = (float*)(P.ws + WS_HCTX);
    if (mode == 0) { load_mod<false>(m1, P, 0, 1, tid); load_mod<false>(m2, P, 0, 0, tid);
        float* adaf = (float*)(P.ws + WS_ADAF);
        for (int i = blockIdx.x * NTHREADS + tid; i < 2 * 3 * 6144; i += gridDim.x * NTHREADS) { const int l_ = i / (3 * 6144), r_ = i % (3 * 6144); adaf[i] = ada_value(P, l_, r_ / 6144, r_ % 6144); } }
    else if (mode == 1) { load_mod<true>(m0, P, l, 2, tid); load_mod<true>(m1, P, l, 4, tid); load_mod<true>(m2, P, l, 3, tid); }
    else { load_mod<true>(m0, P, l, 5, tid); if (l + 1 < DEPTH) { load_mod<true>(m1, P, l + 1, 1, tid); load_mod<true>(m2, P, l + 1, 0, tid); } }
    __syncthreads();
    const int nrows = (mode == 0 || l == 0) ? MALL : MLAT;
    const int gw = blockIdx.x * NWAVES + wave, NGW = gridDim.x * NWAVES;
#define ROW_PTRS(row_, xin_, delta_) do { const bool lat_ = (row_) < MLAT; \
        if (mode == 0) { xin_ = lat_ ? P.in[0] + (size_t)(row_) * DM : P.in[2] + (size_t)((row_) - MLAT) * DM; delta_ = nullptr; } \
        else if (mode == 1) { xin_ = (l == 0) ? (lat_ ? P.in[0] + (size_t)(row_) * DM : P.in[2] + (size_t)((row_) - MLAT) * DM) : (P.out + (size_t)(row_) * DM); \
            delta_ = (!lat_ && l == 0) ? (const bf16_t*)(P.ws + WS_R2) + (size_t)((row_) - MLAT) * DM : (const bf16_t*)(P.ws + WS_BIG) + (size_t)(row_) * DM; } \
        else { xin_ = lat_ ? P.out + (size_t)(row_) * DM : hctx + (size_t)((row_) - MLAT) * DM; \
            delta_ = (!lat_ && l == 0) ? (const bf16_t*)(P.ws + WS_MIX) + (size_t)((row_) - MLAT) * DM : (const bf16_t*)(P.ws + WS_R2) + (size_t)(row_) * DM; } } while (0)
    RowIn cur, nxt;
    if (gw < nrows) { const float* xi; const bf16_t* de; ROW_PTRS(gw, xi, de); row_load(cur, xi, de, lane); }
    for (int row = gw; row < nrows; row += NGW) {
        const bool lat = row < MLAT; const int mid = row < NSEQ ? 0 : (lat ? 1 : 2);
        const float* xin; const bf16_t* delta; ROW_PTRS(row, xin, delta);
        if (row + NGW < nrows) { const float* xi; const bf16_t* de; ROW_PTRS(row + NGW, xi, de); row_load(nxt, xi, de, lane); }
        float* xout = nullptr; const float* gpost = nullptr; const float* gpre = nullptr; bf16_t* aout = nullptr;
        if (mode == 0) { gpre = P.in[6]; aout = A + (size_t)row * DM; }
        else if (mode == 1) { xout = lat ? P.out + (size_t)row * DM : hctx + (size_t)(row - MLAT) * DM; gpost = P.in[7] + l * DM; gpre = P.in[8] + l * DM; aout = A + (size_t)row * DM; }
        else { xout = const_cast<float*>(xin); gpost = P.in[9] + l * DM; if (l + 1 < DEPTH) { gpre = P.in[6] + (l + 1) * DM; aout = A + (size_t)row * DM; } }
        int npart = 1; const size_t pstride = (size_t)512 * DM;
        if (!lat && l == 0) { if (mode == 1) npart = 5; else if (mode == 2) npart = 11; }
        row_pass(cur, delta, npart, pstride, gpost, m0 + mid * 1024, xout, gpre, m1 + mid * 1024, m2 + mid * 1024, aout, lane);
        cur = nxt;
    }
#undef ROW_PTRS
}

template <int MAXIT>
__device__ __forceinline__ void stage_vt(LAS bf16_t* vt, int stride, int koff, const bf16_t* src0, int nkeys, int vlo, int vhi, int tid) {
    bf16x8 v0[MAXIT], v1[MAXIT];
#pragma unroll
    for (int i = 0; i < MAXIT; ++i) { const int u = tid + i * NTHREADS; const int kk = (u >> 3) * 2, dg = u & 7;
        v0[i] = (bf16x8){0, 0, 0, 0, 0, 0, 0, 0}; v1[i] = v0[i];
        if (u < nkeys * 4) { if (kk >= vlo && kk < vhi) v0[i] = *(const bf16x8*)(src0 + (ptrdiff_t)kk * DIN + dg * 8);
                             if (kk + 1 >= vlo && kk + 1 < vhi) v1[i] = *(const bf16x8*)(src0 + (ptrdiff_t)(kk + 1) * DIN + dg * 8); } }
#pragma unroll
    for (int i = 0; i < MAXIT; ++i) { const int u = tid + i * NTHREADS; const int kk = (u >> 3) * 2, dg = u & 7;
        if (u < nkeys * 4) {
#pragma unroll
            for (int e = 0; e < 8; ++e) *(LAS unsigned*)(vt + (dg * 8 + e) * stride + koff + kk) = (unsigned)(unsigned short)v0[i][e] | ((unsigned)(unsigned short)v1[i][e] << 16); } }
}

constexpr int VTS_NA = 584, VTS_SWA = 408, VTS_CTX = 264, VTS_CTXS = 296;

#define MEMBAR() asm volatile("" ::: "memory")
#define SCHEDBAR() __builtin_amdgcn_sched_barrier(0)
template <int NTILE>
__device__ __forceinline__ void softmax_pv_seg(f32x4 (&s)[NTILE], float& m, float& sum, f32x4 (&o)[4], const LAS bf16_t* vb, int vs, int ibase, int istep, int l15) {
    float mx = s[0][0];
#pragma unroll
    for (int j = 0; j < NTILE; ++j) mx = fmaxf(mx, fmaxf(fmaxf(s[j][0], s[j][1]), fmaxf(s[j][2], s[j][3])));
    mx = fmaxf(mx, __shfl_xor(mx, 16)); mx = fmaxf(mx, __shfl_xor(mx, 32));
    const float mn = fmaxf(m, mx);
    const float resc = __expf(m - mn);
    m = mn; sum *= resc;
#pragma unroll
    for (int mt = 0; mt < 4; ++mt) o[mt] = o[mt] * resc;
    float ps = 0.f;
#pragma unroll
    for (int j = 0; j < NTILE; ++j) {
#pragma unroll
        for (int e = 0; e < 4; ++e) { const float p = __expf(s[j][e] - mn); s[j][e] = p; ps += p; } }
    sum += ps;
#pragma unroll
    for (int jj = 0; jj < NTILE / 2; ++jj) {
        const f32x4 p0 = s[2 * jj], p1 = s[2 * jj + 1];
        u32x4 pw; pw.x = pk2(p0[0], p0[1]); pw.y = pk2(p0[2], p0[3]); pw.z = pk2(p1[0], p1[1]); pw.w = pk2(p1[2], p1[3]);
        const bf16x8 pf = __builtin_bit_cast(bf16x8, pw);
        const int i0x = ibase + istep * jj, i1x = i0x + 16;
#pragma unroll
        for (int mt = 0; mt < 4; ++mt) { const LAS bf16_t* vr = vb + (16 * mt + l15) * vs;
            const u32x2 v0 = *(const LAS u32x2*)(vr + i0x), v1 = *(const LAS u32x2*)(vr + i1x);
            u32x4 vw; vw.x = v0.x; vw.y = v0.y; vw.z = v1.x; vw.w = v1.y;
            o[mt] = __builtin_amdgcn_mfma_f32_16x16x32_bf16(__builtin_bit_cast(bf16x8, vw), pf, o[mt], 0, 0, 0); }
    }
}
template <int MODE>
__device__ __forceinline__ void attn_wave(const bf16_t* U, bf16_t* MIX, const LAS bf16_t* vtl, const LAS bf16_t* vtc, const LAS float* rpb,
                                          int b, int qrow  , int qcol_u, int kcol_u, int ocol, bool has_sink, float sinkv,
                                          int a0, int a1, int a2, int a3  , int lane) {
    constexpr int NT = MODE == 1 ? 18 : 16;
    constexpr int VSL = MODE == 0 ? VTS_NA : VTS_SWA, VSC = MODE == 1 ? VTS_CTXS : VTS_CTX;
    const int l15 = lane & 15, q = lane >> 4;
    const bf16_t* qp = U + (size_t)(qrow + l15) * DIN + qcol_u + 8 * q;
    const bf16x8 qf0 = *(const bf16x8*)qp, qf1 = *(const bf16x8*)(qp + 32);
    const float NEG = -__builtin_inff();
    float m = NEG, sum = 0.f;
    f32x4 o[4];
#pragma unroll
    for (int mt = 0; mt < 4; ++mt) o[mt] = (f32x4){0.f, 0.f, 0.f, 0.f};
    const int r = a0, cb = a1, rs = a2, rsA = a3;
    const int bs = min(max(16 * cb - 8, 0), 32), qc = cb * 16 + l15, cs = min(max(qc - 8, 0), 48);
    const int i0 = a0, tq = i0 + l15;
#pragma unroll 1
    for (int seg = (MODE == 2 ? 1 : 0); seg < 2; ++seg) {
        f32x4 s[NT];
#pragma unroll
        for (int j = 0; j < NT; ++j) {
            int krow;
            if (seg == 0) { if (MODE == 0) krow = b * NSEQ + (rs + (j >> 1)) * 64 + bs + 16 * (j & 1) + l15; else krow = b * NSEQ + min(max(i0 - 128 + 16 * j + l15, 0), NSEQ - 1); }
            else krow = MLAT + b * NCTX + (j < 16 ? 16 * j : 240) + l15;
            const bf16_t* kp = U + (size_t)krow * DIN + kcol_u + 8 * q;
            const bf16x8 k0 = *(const bf16x8*)kp, k1 = *(const bf16x8*)(kp + 32);
            f32x4 t = {0.f, 0.f, 0.f, 0.f};
            t = __builtin_amdgcn_mfma_f32_16x16x32_bf16(k0, qf0, t, 0, 0, 0); t = __builtin_amdgcn_mfma_f32_16x16x32_bf16(k1, qf1, t, 0, 0, 0);
#pragma unroll
            for (int e = 0; e < 4; ++e) {
                float v = t[e] * 0.125f; bool ok = (j < 16);
                if (seg == 0) {
                    if (MODE == 0) { const int kr = rs + (j >> 1), kc = bs + 16 * (j & 1) + 4 * q + e; ok = (kc >= cs) && (kc < cs + 16);
                        const int dc = min(max(kc - qc + 15, 0), 30); v += rpb[(kr - r + 7) * 31 + dc]; }
                    else if (MODE == 1) { const int sp = i0 - 128 + 16 * j + 4 * q + e; const int rel = sp - tq; ok = (rel <= 128) && (rel >= -128) && (sp >= 0) && (sp < NSEQ); }
                }
                t[e] = ok ? v : NEG; }
            s[j] = t; if ((j & 7) == 7) __builtin_amdgcn_sched_barrier(0); }
        const LAS bf16_t* vb = seg ? vtc : vtl; const int vs = seg ? VSC : VSL;
        int ibase, istep;
        if (seg) { ibase = 4 * q; istep = 32; }
        else if (MODE == 0) { ibase = (rs - rsA) * 64 + bs + 4 * q; istep = 64; }
        else { ibase = a1 + 4 * q; istep = 32; }
        softmax_pv_seg<NT>(s, m, sum, o, vb, vs, ibase, istep, l15);
    }
    sum += __shfl_xor(sum, 16); sum += __shfl_xor(sum, 32);
    if (has_sink) { const float mn = fmaxf(m, sinkv); const float resc = __expf(m - mn); sum = sum * resc + __expf(sinkv - mn);
#pragma unroll
        for (int mt = 0; mt < 4; ++mt) o[mt] = o[mt] * resc; }
    float inv = 1.f / sum;
    if ((DBG_ZERO & 1) && (MODE == 0 || (MODE == 2 && !has_sink))) inv = 0.f;
    if ((DBG_ZERO & 2) && (MODE == 1 || (MODE == 2 && has_sink))) inv = 0.f;
    bf16_t* op = MIX + (size_t)(qrow + l15) * KOUT + ocol + 4 * q;
#pragma unroll
    for (int mt = 0; mt < 4; ++mt) { u32x2 w; w.x = pk2(o[mt][0] * inv, o[mt][1] * inv); w.y = pk2(o[mt][2] * inv, o[mt][3] * inv); *(u32x2*)(op + 16 * mt) = w; }
}

__device__ __forceinline__ void na_item(const Params& P, LAS unsigned char* lds, int l, int item, int W0) {
    const int tid = opaque_tid(W0), lane = tid & 63, wave = tid >> 6;
    const int b = item >> 8, h = (item >> 6) & 3, rp = item & 63, r0 = 2 * rp;
    const bf16_t* U = (const bf16_t*)(P.ws + WS_BIG); bf16_t* MIX = (bf16_t*)(P.ws + WS_MIX);
    LAS bf16_t* vtl = (LAS bf16_t*)lds; LAS bf16_t* vtc = vtl + 64 * VTS_NA; LAS float* rpb = (LAS float*)(vtc + 64 * VTS_CTX);
    const int rsA = min(max(r0 - 4, 0), 120); const int nrows = min(9, 128 - rsA);
    stage_vt<5>(vtl, VTS_NA, 0, U + (size_t)(b * NSEQ + rsA * 64) * DIN + C_VA + h * 64, nrows * 64, 0, nrows * 64, tid);
    stage_vt<2>(vtc, VTS_CTX, 0, U + (size_t)(MLAT + b * NCTX) * DIN + C_VA + h * 64, 256, 0, 256, tid);
    for (int i = tid; i < 15 * 31; i += NTHREADS) rpb[i] = P.in[12][(size_t)(l * 4 + h) * 465 + i];
    __syncthreads();
    const int r = r0 + (wave >> 2), cb = wave & 3; const int rs = min(max(r - 4, 0), 120);
    attn_wave<0>(U, MIX, vtl, vtc, rpb, b, b * NSEQ + r * 64 + cb * 16, C_QA + h * 64, C_KA + h * 64, O_A + h * 64, false, 0.f, r, cb, rs, rsA, lane);
    __syncthreads();
}
__device__ __forceinline__ void swa_item(const Params& P, LAS unsigned char* lds, int l, int item, int W0) {
    const int tid = opaque_tid(W0), lane = tid & 63, wave = tid >> 6;
    const int b = item >> 8, hq = (item >> 6) & 3, nb = item & 63, g = hq >> 1;
    const bf16_t* U = (const bf16_t*)(P.ws + WS_BIG); bf16_t* MIX = (bf16_t*)(P.ws + WS_MIX);
    LAS bf16_t* vtl = (LAS bf16_t*)lds; LAS bf16_t* vtc = vtl + 64 * VTS_SWA;
    const int tok0 = (nb - 1) * 128;
    stage_vt<4>(vtl, VTS_SWA, 0, U + ((ptrdiff_t)b * NSEQ + tok0) * DIN + C_VS + g * 64, 400, max(0, -tok0), min(400, NSEQ - tok0), tid);
    stage_vt<3>(vtc, VTS_CTXS, 0, U + (size_t)(MLAT + b * NCTX) * DIN + C_VS + g * 64, 288, 0, 256, tid);
    __syncthreads();
    const int i0 = nb * 128 + 16 * wave;
    attn_wave<1>(U, MIX, vtl, vtc, nullptr, b, b * NSEQ + i0, C_QS + hq * 64, C_KS + g * 64, O_C + hq * 64, true, P.in[14][l * 4 + hq], i0, 16 * wave, 0, 0, lane);
    __syncthreads();
}
__device__ __forceinline__ void ctxattn_item(const Params& P, LAS unsigned char* lds, int l, int item, int W0) {
    const int tid = opaque_tid(W0), lane = tid & 63, wave = tid >> 6;
    const bool swa = item >= 16; const int it = item & 15; const int b = it >> 3, hh = (it >> 1) & 3, half = it & 1;
    const bf16_t* U = (const bf16_t*)(P.ws + WS_BIG); bf16_t* MIX = (bf16_t*)(P.ws + WS_MIX);
    LAS bf16_t* vtc = (LAS bf16_t*)lds;
    const int vcol = swa ? C_VS + (hh >> 1) * 64 : C_VA + hh * 64;
    stage_vt<2>(vtc, VTS_CTX, 0, U + (size_t)(MLAT + b * NCTX) * DIN + vcol, 256, 0, 256, tid);
    __syncthreads();
    const int qrow = MLAT + b * NCTX + half * 128 + 16 * wave;
    if (swa) attn_wave<2>(U, MIX, nullptr, vtc, nullptr, b, qrow, C_QS + hh * 64, C_KS + (hh >> 1) * 64, O_C + hh * 64, true, P.in[14][l * 4 + hh], 0, 0, 0, 0, lane);
    else     attn_wave<2>(U, MIX, nullptr, vtc, nullptr, b, qrow, C_QA + hh * 64, C_KA + hh * 64, O_A + hh * 64, false, 0.f, 0, 0, 0, 0, lane);
    __syncthreads();
}

__device__ __forceinline__ float hgrn_lb(const Params& P, int l, int dir, int k256) {
    if (l == 0) return 0.f;
    const float l0 = P.in[15][(size_t)(dir * DEPTH + 0) * 256 + k256], l1 = P.in[15][(size_t)(dir * DEPTH + 1) * 256 + k256];
    return 1.f / (1.f + __expf(l0 - l1));
}
template <bool OUT>
__device__ __forceinline__ void hgrn_item(const Params& P, LAS unsigned char* lds, int l, int item, int W0) {
    const int tid = opaque_tid(W0), lane = tid & 63, wave = tid >> 6;
    const int b = item / NCHUNK, c = item % NCHUNK;
    const int h = wave & 3, dir = wave >> 2;
    const int row0 = c < 4 ? MLAT + b * NCTX + c * 64 : b * NSEQ + (c - 4) * 64;
    const int pos = dir == 0 ? c : (c < 4 ? 3 - c : 135 - c);
    const int chain = (b * 4 + h) * 2 + dir;
    const bf16_t* U = (const bf16_t*)(P.ws + WS_BIG);
    float* HL = (float*)(P.ws + WS_R2) + ((size_t)chain * NCHUNK + pos) * 4096;
    float* HD = (float*)(P.ws + WS_HD) + ((size_t)chain * NCHUNK + pos) * 64;
    LAS float* OB = (LAS float*)lds;
    LAS float* stg = (LAS float*)(lds + 65536) + wave * 2048;
    const float lb = hgrn_lb(P, l, dir, h * 64 + lane);
    const int fcol = (dir == 0 ? C_FF : C_FB) + h * 64 + lane;
    float S[64];
    if (OUT) {
        for (int i = tid; i < 4 * 64 * 64; i += NTHREADS) OB[i] = 0.f;
        if (c >= 4) {
#pragma unroll
            for (int j = 0; j < 64; ++j) S[j] = HL[j * 64 + lane];
        } else {
#pragma unroll
            for (int j = 0; j < 64; ++j) S[j] = 0.f;
            for (int pp = 0; pp < pos; ++pp) { const float* Lp = (const float*)(P.ws + WS_R2) + ((size_t)chain * NCHUNK + pp) * 4096; const float* Dp = (const float*)(P.ws + WS_HD) + ((size_t)chain * NCHUNK + pp) * 64;
#pragma unroll
                for (int j = 0; j < 64; ++j) S[j] = Dp[j] * S[j] + Lp[j * 64 + lane]; }
        }
        __syncthreads();
    } else {
#pragma unroll
        for (int j = 0; j < 64; ++j) S[j] = 0.f;
    }
    float D = 1.f;
    for (int sub = 0; sub < 4; ++sub) {
        float vv[16];
#pragma unroll
        for (int st = 0; st < 16; ++st) { const int step = sub * 16 + st; const int t = dir == 0 ? step : 63 - step; const bf16_t* ur = U + (size_t)(row0 + t) * DIN;
            const float fz = bf2f(ur[fcol]); const float f = lb + (1.f - lb) * sigmoidf_(fz); D *= f;
            stg[st * 128 + lane] = f;
            if (OUT) stg[st * 128 + 64 + lane] = siluf(bf2f(ur[C_QD + h * 64 + lane]));
            vv[st] = bf2f(ur[C_IV + h * 64 + lane]); }
#pragma unroll
        for (int st = 0; st < 16; ++st) { const float v = vv[st]; const LAS f32x4* fp = (const LAS f32x4*)(stg + st * 128); float oa = 0.f, ob = 0.f, oc = 0.f, od = 0.f;
#pragma unroll
            for (int j4 = 0; j4 < 16; ++j4) { if ((j4 & HG_BAR) == 0) MEMBAR(); const f32x4 f4 = fp[j4];
                S[4 * j4 + 0] = __builtin_fmaf(f4[0], S[4 * j4 + 0] - v, v); S[4 * j4 + 1] = __builtin_fmaf(f4[1], S[4 * j4 + 1] - v, v);
                S[4 * j4 + 2] = __builtin_fmaf(f4[2], S[4 * j4 + 2] - v, v); S[4 * j4 + 3] = __builtin_fmaf(f4[3], S[4 * j4 + 3] - v, v);
                if (OUT) { const f32x4 q4 = fp[16 + j4]; oa += S[4 * j4 + 0] * q4[0]; ob += S[4 * j4 + 1] * q4[1]; oc += S[4 * j4 + 2] * q4[2]; od += S[4 * j4 + 3] * q4[3]; } }
            if (OUT) { const int step = sub * 16 + st; const int t = dir == 0 ? step : 63 - step; atomicAdd((float*)(OB + (h * 64 + t) * 64 + lane), (oa + ob) + (oc + od)); } }
    }
    if (!OUT) {
#pragma unroll
        for (int j = 0; j < 64; ++j) HL[j * 64 + lane] = S[j];
        HD[lane] = D;
    } else {
        __syncthreads();
        bf16_t* MIX = (bf16_t*)(P.ws + WS_MIX);
        for (int p0 = wave; p0 < 256; p0 += 8 * NWAVES) {
            float gz[8], val[8];
#pragma unroll
            for (int i = 0; i < 8; ++i) { const int pr = p0 + i * NWAVES, hh = pr >> 6, t = pr & 63; gz[i] = bf2f(U[(size_t)(row0 + t) * DIN + C_GD + hh * 64 + lane]); val[i] = OB[(hh * 64 + t) * 64 + lane]; }
#pragma unroll
            for (int i = 0; i < 8; ++i) { const int pr = p0 + i * NWAVES, hh = pr >> 6, t = pr & 63;
                const float rstd = rsqrtf(wave_sum(val[i] * val[i]) * (1.f / 64.f) + EPS);
                const float gn = P.in[16][l * 256 + hh * 64 + lane];
                MIX[(size_t)(row0 + t) * KOUT + O_D + hh * 64 + lane] = (bf16_t)f2bf((DBG_ZERO & 4) ? 0.f : val[i] * rstd * gn * siluf(gz[i])); }
        }
        __syncthreads();
    }
}

__device__ __forceinline__ void hgrn_state_item(const Params& P, LAS unsigned char* lds, int l, int item, int W0) {
    const int tid = opaque_tid(W0), lane = tid & 63, wave = tid >> 6, l15 = lane & 15, q = lane >> 4;
    const int b = item / NCHUNK, c = item % NCHUNK;
    const int h = wave & 3, dir = wave >> 2;
    const int row0 = c < 4 ? MLAT + b * NCTX + c * 64 : b * NSEQ + (c - 4) * 64;
    const int pos = dir == 0 ? c : (c < 4 ? 3 - c : 135 - c);
    const int chain = (b * 4 + h) * 2 + dir;
    const bf16_t* U = (const bf16_t*)(P.ws + WS_BIG);
    float* HL = (float*)(P.ws + WS_R2) + ((size_t)chain * NCHUNK + pos) * 4096;
    float* HD = (float*)(P.ws + WS_HD) + ((size_t)chain * NCHUNK + pos) * 64;
    constexpr int RS = 72;
    LAS bf16_t* VT = (LAS bf16_t*)lds + h * 64 * RS;
    LAS bf16_t* KH = (LAS bf16_t*)lds + 4 * 64 * RS + wave * 64 * RS;
    const float lb = hgrn_lb(P, l, dir, h * 64 + lane);
    const int fcol = (dir == 0 ? C_FF : C_FB) + h * 64 + lane;
    float p = 1.f;
    for (int sb = 0; sb < 4; ++sb) {
        float fz[16]; unsigned short vv[16];
#pragma unroll
        for (int i = 0; i < 16; ++i) { const int step = 63 - (sb * 16 + i); const int t = dir == 0 ? step : 63 - step; const bf16_t* ur = U + (size_t)(row0 + t) * DIN;
            fz[i] = bf2f(ur[fcol]); vv[i] = (dir == 0) ? ur[C_IV + h * 64 + lane] : (unsigned short)0; }
#pragma unroll
        for (int i = 0; i < 16; i += 2) {
            const int st0 = 63 - (sb * 16 + i), st1 = st0 - 1; const int t0 = dir == 0 ? st0 : 63 - st0, t1 = dir == 0 ? st1 : 63 - st1;
            const float f0 = lb + (1.f - lb) * sigmoidf_(fz[i]); const float k0 = (1.f - f0) * p; p *= f0;
            const float f1 = lb + (1.f - lb) * sigmoidf_(fz[i + 1]); const float k1 = (1.f - f1) * p; p *= f1;
            const int te = t0 < t1 ? t0 : t1; const unsigned lo = f2bf(t0 < t1 ? k0 : k1), hi = f2bf(t0 < t1 ? k1 : k0);
            *(LAS unsigned*)(KH + lane * RS + te) = lo | (hi << 16);
            if (dir == 0) { const unsigned vlo = t0 < t1 ? vv[i] : vv[i + 1], vhi = t0 < t1 ? vv[i + 1] : vv[i]; *(LAS unsigned*)(VT + lane * RS + te) = vlo | (vhi << 16); }
        }
    }
    HD[lane] = p;
    __syncthreads();
    f32x4 acc[4][4];
#pragma unroll
    for (int mt = 0; mt < 4; ++mt)
#pragma unroll
        for (int nt = 0; nt < 4; ++nt) acc[mt][nt] = (f32x4){0.f, 0.f, 0.f, 0.f};
#pragma unroll
    for (int ks = 0; ks < 2; ++ks) {
        bf16x8 bfr[4];
#pragma unroll
        for (int nt = 0; nt < 4; ++nt) bfr[nt] = *(const LAS bf16x8*)(VT + (16 * nt + l15) * RS + 32 * ks + 8 * q);
#pragma unroll
        for (int mt = 0; mt < 4; ++mt) { const bf16x8 afr = *(const LAS bf16x8*)(KH + (16 * mt + l15) * RS + 32 * ks + 8 * q);
#pragma unroll
            for (int nt = 0; nt < 4; ++nt) acc[mt][nt] = __builtin_amdgcn_mfma_f32_16x16x32_bf16(afr, bfr[nt], acc[mt][nt], 0, 0, 0); }
    }
#pragma unroll
    for (int mt = 0; mt < 4; ++mt)
#pragma unroll
        for (int nt = 0; nt < 4; ++nt)
            *(f32x4*)(HL + ((mt * 4 + nt) * 64 + lane) * 4) = acc[mt][nt];
    __syncthreads();
}

__device__ __forceinline__ float frcp(float x) { return __builtin_amdgcn_rcpf(x); }
__device__ __forceinline__ float fsigmoid(float a) { return frcp(1.f + __expf(-a)); }
__device__ __forceinline__ float fsilu(float a) { return a * frcp(1.f + __expf(-a)); }
#define HG_LOAD_SB(SB) do { if (dir == 0) { const bf16_t* up = Ub + (size_t)((SB) * 16) * DIN; \
        _Pragma("unroll") for (int s_ = 0; s_ < 16; ++s_) { nfz[s_] = up[C_FF]; nqv[s_] = up[C_QD]; nvv[s_] = up[C_IV]; up += DIN; } } \
    else { const bf16_t* up = Ub + (size_t)(63 - (SB) * 16) * DIN; \
        _Pragma("unroll") for (int s_ = 0; s_ < 16; ++s_) { nfz[s_] = up[C_FB]; nqv[s_] = up[C_QD]; nvv[s_] = up[C_IV]; up -= DIN; } } } while (0)
__device__ __forceinline__ void hgrn_out_item(const Params& P, LAS unsigned char* lds, int l, int item, int W0) {
    const int tid = opaque_tid(W0), lane = tid & 63, wave = tid >> 6, l15 = lane & 15, q = lane >> 4;
    const int b = item / NCHUNK, c = item % NCHUNK;
    const int h = wave & 3, dir = wave >> 2;
    const int row0 = c < 4 ? MLAT + b * NCTX + c * 64 : b * NSEQ + (c - 4) * 64;
    const int pos = dir == 0 ? c : (c < 4 ? 3 - c : 135 - c);
    const int chain = (b * 4 + h) * 2 + dir;
    const bf16_t* U = (const bf16_t*)(P.ws + WS_BIG);
    const float* HLb = (const float*)(P.ws + WS_R2) + (size_t)chain * NCHUNK * 4096;
    const float* HDb = (const float*)(P.ws + WS_HD) + (size_t)chain * NCHUNK * 64;
    constexpr int OS = 66;
    LAS bf16_t* OBd = (LAS bf16_t*)lds + dir * (4 * 64 * OS);
    constexpr int QS = 68, ES = 20;
    LAS unsigned char* wb = lds + 2 * 4 * 64 * OS * 2 + wave * 9728;
    LAS bf16_t* QT = (LAS bf16_t*)wb;
    LAS bf16_t* KT = QT + 16 * QS;
    LAS bf16_t* KE = KT + 16 * QS;
    LAS bf16_t* VT = KE + 64 * ES;
    LAS float* A15 = (LAS float*)(VT + 64 * ES);
    const float lb = hgrn_lb(P, l, dir, h * 64 + lane);
    const int fcol = (dir == 0 ? C_FF : C_FB) + h * 64 + lane;
    f32x4 S[4][4];
    if (c >= 4) { const float* Hp = HLb + (size_t)pos * 4096;
#pragma unroll
        for (int mt = 0; mt < 4; ++mt)
#pragma unroll
            for (int nt = 0; nt < 4; ++nt)
                S[mt][nt] = *(const f32x4*)(Hp + ((mt * 4 + nt) * 64 + lane) * 4);
    } else {
#pragma unroll
        for (int mt = 0; mt < 4; ++mt)
#pragma unroll
            for (int nt = 0; nt < 4; ++nt) S[mt][nt] = (f32x4){0.f, 0.f, 0.f, 0.f};
        for (int pp = 0; pp < pos; ++pp) { const float* Lp = HLb + (size_t)pp * 4096; const float* Dp = HDb + pp * 64;
#pragma unroll
            for (int mt = 0; mt < 4; ++mt) { const f32x4 d4 = *(const f32x4*)(Dp + 16 * mt + 4 * q);
#pragma unroll
                for (int nt = 0; nt < 4; ++nt)
                    S[mt][nt] = d4 * S[mt][nt] + *(const f32x4*)(Lp + ((mt * 4 + nt) * 64 + lane) * 4); } }
    }
    __syncthreads();
    unsigned short nfz[16], nqv[16], nvv[16];
    const bf16_t* Ub = U + (size_t)row0 * DIN + h * 64 + lane;
    HG_LOAD_SB(0);
    for (int sb = 0; sb < 4; ++sb) {
        float fz[16], qv[16]; unsigned short vv[16];
#pragma unroll
        for (int s_ = 0; s_ < 16; ++s_) { fz[s_] = bf2f(nfz[s_]); qv[s_] = bf2f(nqv[s_]); vv[s_] = nvv[s_]; }
        if (sb < 3) HG_LOAD_SB(sb + 1);
        float a[16], kk[16]; float ap = 1.f;
#pragma unroll
        for (int s_ = 0; s_ < 16; ++s_) { const float f = lb + (1.f - lb) * fsigmoid(fz[s_]); ap *= f; a[s_] = fmaxf(ap, 1e-30f); kk[s_] = 1.f - f; }
        const float a15 = a[15];
        A15[lane] = a15;
#pragma unroll
        for (int s_ = 0; s_ < 16; s_ += 2) {
            const float ia0 = frcp(a[s_]), ia1 = frcp(a[s_ + 1]);
            const unsigned qp = pk2(fsilu(qv[s_]) * a[s_], fsilu(qv[s_ + 1]) * a[s_ + 1]), kp = pk2(kk[s_] * ia0, kk[s_ + 1] * ia1);
            QT[s_ * QS + lane] = (bf16_t)qp; QT[(s_ + 1) * QS + lane] = (bf16_t)(qp >> 16);
            KT[s_ * QS + lane] = (bf16_t)kp; KT[(s_ + 1) * QS + lane] = (bf16_t)(kp >> 16);
            *(LAS unsigned*)(KE + lane * ES + s_) = pk2(kk[s_] * a15 * ia0, kk[s_ + 1] * a15 * ia1);
            *(LAS unsigned*)(VT + lane * ES + s_) = (unsigned)vv[s_] | ((unsigned)vv[s_ + 1] << 16);
        }
        MEMBAR();
        bf16x8 qfr[2], kfr[2];
#pragma unroll
        for (int ks = 0; ks < 2; ++ks) {
            const u32x2 q0 = *(const LAS u32x2*)(QT + l15 * QS + 32 * ks + 4 * q), q1 = *(const LAS u32x2*)(QT + l15 * QS + 32 * ks + 16 + 4 * q);
            const u32x2 k0 = *(const LAS u32x2*)(KT + l15 * QS + 32 * ks + 4 * q), k1 = *(const LAS u32x2*)(KT + l15 * QS + 32 * ks + 16 + 4 * q);
            u32x4 qw; qw.x = q0.x; qw.y = q0.y; qw.z = q1.x; qw.w = q1.y; qfr[ks] = __builtin_bit_cast(bf16x8, qw);
            u32x4 kw; kw.x = k0.x; kw.y = k0.y; kw.z = k1.x; kw.w = k1.y; kfr[ks] = __builtin_bit_cast(bf16x8, kw);
        }
        f32x4 att = {0.f, 0.f, 0.f, 0.f};
        att = __builtin_amdgcn_mfma_f32_16x16x32_bf16(kfr[0], qfr[0], att, 0, 0, 0); att = __builtin_amdgcn_mfma_f32_16x16x32_bf16(kfr[1], qfr[1], att, 0, 0, 0);
#pragma unroll
        for (int e = 0; e < 4; ++e) att[e] = (4 * q + e <= l15) ? att[e] : 0.f;
        u32x4 pw; pw.x = pk2(att[0], att[1]); pw.y = pk2(att[2], att[3]); pw.z = 0u; pw.w = 0u;
        const bf16x8 pfr = __builtin_bit_cast(bf16x8, pw);
        f32x4 oT[4];
#pragma unroll
        for (int nt = 0; nt < 4; ++nt) {
            f32x4 o = {0.f, 0.f, 0.f, 0.f};
#pragma unroll
            for (int ks = 0; ks < 2; ++ks) { const f32x4 s0 = S[2 * ks][nt], s1 = S[2 * ks + 1][nt];
                u32x4 sw; sw.x = pk2(s0[0], s0[1]); sw.y = pk2(s0[2], s0[3]); sw.z = pk2(s1[0], s1[1]); sw.w = pk2(s1[2], s1[3]);
                o = __builtin_amdgcn_mfma_f32_16x16x32_bf16(__builtin_bit_cast(bf16x8, sw), qfr[ks], o, 0, 0, 0); }
            const u32x2 v0 = *(const LAS u32x2*)(VT + (16 * nt + l15) * ES + 4 * q);
            u32x4 vw; vw.x = v0.x; vw.y = v0.y; vw.z = 0u; vw.w = 0u;
            o = __builtin_amdgcn_mfma_f32_16x16x32_bf16(__builtin_bit_cast(bf16x8, vw), pfr, o, 0, 0, 0);
            oT[nt] = o;
        }
#pragma unroll
        for (int mt = 0; mt < 4; ++mt) { const f32x4 a4 = *(const LAS f32x4*)(A15 + 16 * mt + 4 * q);
            const u32x2 e0 = *(const LAS u32x2*)(KE + (16 * mt + l15) * ES + 4 * q);
            u32x4 ew; ew.x = e0.x; ew.y = e0.y; ew.z = 0u; ew.w = 0u; const bf16x8 efr = __builtin_bit_cast(bf16x8, ew);
#pragma unroll
            for (int nt = 0; nt < 4; ++nt) { const u32x2 v0 = *(const LAS u32x2*)(VT + (16 * nt + l15) * ES + 4 * q);
                u32x4 vw; vw.x = v0.x; vw.y = v0.y; vw.z = 0u; vw.w = 0u;
                S[mt][nt] = __builtin_amdgcn_mfma_f32_16x16x32_bf16(efr, __builtin_bit_cast(bf16x8, vw), S[mt][nt] * a4, 0, 0, 0); } }
        { const int step = sb * 16 + l15; const int t = dir == 0 ? step : 63 - step; LAS bf16_t* orow = OBd + (h * 64 + t) * OS + 4 * q;
#pragma unroll
          for (int nt = 0; nt < 4; ++nt) { *(LAS unsigned*)(orow + 16 * nt) = pk2(oT[nt][0], oT[nt][1]); *(LAS unsigned*)(orow + 16 * nt + 2) = pk2(oT[nt][2], oT[nt][3]); } }
        MEMBAR();
    }
    __syncthreads();
    {
        bf16_t* MIX = (bf16_t*)(P.ws + WS_MIX);
        for (int p0 = wave; p0 < 256; p0 += 8 * NWAVES) {
            float gz[8], val[8];
#pragma unroll
            for (int i = 0; i < 8; ++i) { const int pr = p0 + i * NWAVES, hh = pr >> 6, t = pr & 63; gz[i] = bf2f(U[(size_t)(row0 + t) * DIN + C_GD + hh * 64 + lane]); val[i] = bf2f(((const LAS bf16_t*)lds)[(hh * 64 + t) * OS + lane]) + bf2f(((const LAS bf16_t*)lds)[4 * 64 * OS + (hh * 64 + t) * OS + lane]); }
#pragma unroll
            for (int i = 0; i < 8; ++i) { const int pr = p0 + i * NWAVES, hh = pr >> 6, t = pr & 63;
                const float rstd = rsqrtf(wave_sum(val[i] * val[i]) * (1.f / 64.f) + EPS);
                const float gn = P.in[16][l * 256 + hh * 64 + lane];
                MIX[(size_t)(row0 + t) * KOUT + O_D + hh * 64 + lane] = (bf16_t)f2bf(val[i] * rstd * gn * fsilu(gz[i])); }
        }
    }
    __syncthreads();
}
__device__ __forceinline__ void hgrn_prefix_item(const Params& P, int item, int W0) {
    const int e = item * NTHREADS + opaque_tid(W0); const int chain = e >> 12, kv = e & 4095, k = 16 * (kv >> 10) + 4 * ((kv >> 6) & 3) + (kv & 3);
    float* HL = (float*)(P.ws + WS_R2) + (size_t)chain * NCHUNK * 4096 + kv;
    const float* HD = (const float*)(P.ws + WS_HD) + (size_t)chain * NCHUNK * 64 + k;
    float S = 0.f;
    for (int p0 = 0; p0 < NCHUNK; p0 += 12) { float tv[12], dv[12];
#pragma unroll
        for (int i = 0; i < 12; ++i) { tv[i] = HL[(size_t)(p0 + i) * 4096]; dv[i] = HD[(p0 + i) * 64]; }
#pragma unroll
        for (int i = 0; i < 12; ++i) { if (p0 + i >= 4) HL[(size_t)(p0 + i) * 4096] = S; S = dv[i] * S + tv[i]; } }
}

template <int MODE>
__device__ __forceinline__ void fnet_item(const Params& P, LAS unsigned char* lds, int item, int W0) {
    constexpr int KD = MODE == 0 ? 64 : 256, R = MODE == 0 ? 128 : (MODE == 1 ? 256 : 512), DS = KD + 8;
    const int tid = opaque_tid(W0), lane = tid & 63, wave = tid >> 6, l15 = lane & 15, q = lane >> 4;
    const bf16_t* U = (const bf16_t*)(P.ws + WS_BIG); bf16_t* MIX = (bf16_t*)(P.ws + WS_MIX); bf16_t* Y = (bf16_t*)(P.ws + WS_A);
    LAS bf16_t* DT = (LAS bf16_t*)lds;
    const bf16_t* T = (const bf16_t*)(P.ws + (MODE == 0 ? WS_TA : (MODE == 1 ? WS_TC : WS_TCTX)));
    const int b = MODE == 2 ? item : item >> (MODE == 0 ? 7 : 6);
    const int sub = MODE == 0 ? (item & 127) : (MODE == 1 ? (item & 63) : 0);
    for (int u = tid; u < KD * 16; u += NTHREADS) { const int kk = (u >> 5) * 2, cg8 = (u & 31) * 8; const bf16_t* src0; const bf16_t* src1;
        if (MODE == 0) { src0 = U + (size_t)(b * NSEQ + 128 * kk + sub) * DIN + C_UB + cg8; src1 = src0 + (size_t)128 * DIN; }
        else if (MODE == 1) { const int p = kk >> 7, t2 = kk & 127; src0 = Y + ((size_t)((b * 64 + sub) * 128 + t2) * 2 + p) * 256 + cg8; src1 = src0 + 512;
#ifdef DBG_CONSTSRC
            src0 = T + (size_t)kk * 256 + cg8; src1 = src0 + 256;
#endif
        }
        else { src0 = U + (size_t)(MLAT + b * NCTX + kk) * DIN + C_UB + cg8; src1 = src0 + DIN; }
        const bf16x8 v0 = *(const bf16x8*)src0, v1 = *(const bf16x8*)src1;
#pragma unroll
        for (int e = 0; e < 8; ++e) *(LAS unsigned*)(DT + (cg8 + e) * DS + kk) = (unsigned)(unsigned short)v0[e] | ((unsigned)(unsigned short)v1[e] << 16); }
    __syncthreads();
    bf16x8 df[2][KD / 32];
#pragma unroll
    for (int ct = 0; ct < 2; ++ct)
#pragma unroll
        for (int ks = 0; ks < KD / 32; ++ks) df[ct][ks] = *(const LAS bf16x8*)(DT + ((2 * wave + ct) * 16 + l15) * DS + 32 * ks + 8 * q);
    for (int rt = 0; rt < R / 32; ++rt) {
        f32x4 acc[2][2];
#pragma unroll
        for (int ct = 0; ct < 2; ++ct)
#pragma unroll
            for (int p = 0; p < 2; ++p) acc[ct][p] = (f32x4){0.f, 0.f, 0.f, 0.f};
#pragma unroll
        for (int ks = 0; ks < KD / 32; ++ks) {
            const bf16x8 t0 = *(const bf16x8*)(T + (size_t)(16 * rt + l15) * KD + 32 * ks + 8 * q);
            const bf16x8 t1 = *(const bf16x8*)(T + (size_t)(R / 2 + 16 * rt + l15) * KD + 32 * ks + 8 * q);
#pragma unroll
            for (int ct = 0; ct < 2; ++ct) { acc[ct][0] = __builtin_amdgcn_mfma_f32_16x16x32_bf16(df[ct][ks], t0, acc[ct][0], 0, 0, 0);
                                             acc[ct][1] = __builtin_amdgcn_mfma_f32_16x16x32_bf16(df[ct][ks], t1, acc[ct][1], 0, 0, 0); }
        }
        const int rr = 16 * rt + l15;
        float tc = 1.f, tsn = 0.f;
        if (MODE == 0) sincospif((float)(rr * sub) * (1.f / 4096.f), &tsn, &tc);
#pragma unroll
        for (int ct = 0; ct < 2; ++ct) { const int ch = (2 * wave + ct) * 16 + 4 * q; f32x4 re = acc[ct][0], im = acc[ct][1];
            if (MODE == 0) { const f32x4 r2 = re * tc + im * tsn, i2 = im * tc - re * tsn; re = r2; im = i2; }
            if ((DBG_ZERO & 8) && MODE != 0) { re = re * 0.f; im = im * 0.f; }
            if ((DBG_ZERO & 64) && MODE != 0) { im = im * 0.f; }
            if ((DBG_ZERO & 128) && MODE != 0) { re = re * 0.f; }
            u32x2 wr_, wi_; wr_.x = pk2(re[0], re[1]); wr_.y = pk2(re[2], re[3]); wi_.x = pk2(im[0], im[1]); wi_.y = pk2(im[2], im[3]);
            if (MODE == 0) { bf16_t* yp = Y + ((size_t)((b * 64 + rr) * 128 + sub) * 2) * 256 + ch; *(u32x2*)yp = wr_; *(u32x2*)(yp + 256) = wi_; }
            else { const size_t row = MODE == 1 ? (size_t)(b * NSEQ + sub + 64 * rr) : (size_t)(MLAT + b * NCTX + rr); bf16_t* mp = MIX + row * KOUT + O_Z + ch; *(u32x2*)mp = wr_; *(u32x2*)(mp + 256) = wi_; }
        }
    }
    __syncthreads();
}


__device__ __forceinline__ void phase_m1(const Params& P_, LAS unsigned char* lds, int l, int W0) {
    const Params& P = *kparams();
    const int bid = blockIdx.x;
    for (int k = 0; k < 3; ++k) {
        int type = -1, id = 0;
        if (k == 0) { type = 0; id = (bid >> 7) * NCHUNK + 4 + (bid & 127); }
        else if (k == 1) { if (bid < 8) { type = 0; id = (bid >> 2) * NCHUNK + (bid & 3); } else { type = 1; id = bid - 8; } }
        else { if (bid >= 8 && bid < 16) { type = 1; id = 248 + (bid - 8); } else if (l == 0 && (bid == 16 || bid == 17)) { type = 2; id = bid - 16; } }
        if (type == 0) hgrn_state_item(P, lds, l, id, W0); else if (type == 1) fnet_item<0>(P, lds, id, W0); else if (type == 2) fnet_item<2>(P, lds, id, W0);
    }
    na_item(P, lds, l, bid, W0);
}
__device__ __forceinline__ void phase_m2(const Params& P_, LAS unsigned char* lds, int l, int rep, int W0) {
    const Params& P = *kparams();
    const int bid = blockIdx.x;
    const int NW = (l == 0) ? 248 : 256, wb = (l == 0) ? bid - 8 : bid, NIT = 128 + 128 + 256 + 256 + ((l == 0) ? 32 : 0);
    if (wb < 0) { hgrn_out_item(P, lds, l, (bid >> 2) * NCHUNK + (bid & 3), W0); return; }
    for (int it = wb; it < NIT; it += NW) {
        if (it < 128) fnet_item<1>(P, lds, it, W0);
        else if (it < 256) { if (rep == 0) hgrn_prefix_item(P, it - 128, W0); }
        else if (it < 512) na_item(P, lds, l, 256 + (it - 256), W0);
        else if (it < 768) swa_item(P, lds, l, it - 512, W0);
        else ctxattn_item(P, lds, l, it - 768, W0);
    }
}
__device__ __forceinline__ void phase_m3(const Params& P_, LAS unsigned char* lds, int l, int W0) {
    const Params& P = *kparams();
    const int bid = blockIdx.x;
    for (int rep = 0; rep < ((DBG_DUP2 & 1) ? 2 : 1); ++rep) hgrn_out_item(P, lds, l, (bid >> 7) * NCHUNK + 4 + (bid & 127), W0);
    for (int rep = 0; rep < ((DBG_DUP2 & 2) ? 2 : 1); ++rep) swa_item(P, lds, l, 256 + bid, W0);
}

template <class Epi>
__device__ __forceinline__ void run_gemm(LAS unsigned char* lds, const bf16_t* A, const bf16_t* Bt, int M, int N, int K, const Epi& E, int W0) {
    pg8::Gemm g{A, Bt, M, N, K, K}; pg8::StaticOrder S; S.init(M, N, (int)gridDim.x, (int)blockIdx.x);
    pg8::gemm_phase<Epi, pg8::StaticOrder, true, true>((PG8_LAS unsigned char*)lds, g, S, E, W0);
    __syncthreads();
}
template <class Epi>
__device__ __forceinline__ void run_gemm_split(LAS unsigned char* lds, const bf16_t* A, const bf16_t* Bt, int M, int N, int K, int NS, const Epi& E, int W0) {
    pg8::Gemm g{A, Bt, M, N, K / NS, K}; pg8::SplitOrder S; S.init(M, N, NS, (int)gridDim.x, (int)blockIdx.x);
    pg8::gemm_phase<Epi, pg8::SplitOrder, true, true>((PG8_LAS unsigned char*)lds, g, S, E, W0);
    __syncthreads();
}

#define GAS __attribute__((address_space(1)))
#define XB_TMO      128
#define XB_XCNT(j)  (256  + 64 * (j))
#define XB_XSUB(j)  (1280 + 64 * (j))
#define XB_XGEN(j)  (2304 + 64 * (j))
#define XB_TOP      3328
#define XB_TOPGEN   3392
#define XCD_BAR_WORDS 3456
#define XB_SPIN_CAP (1u << 18)

__device__ __forceinline__ unsigned xb_ld(unsigned* p)              { return __hip_atomic_load(p, __ATOMIC_RELAXED, __HIP_MEMORY_SCOPE_AGENT); }
__device__ __forceinline__ unsigned xb_add(unsigned* p, unsigned v) { return __hip_atomic_fetch_add(p, v, __ATOMIC_RELAXED, __HIP_MEMORY_SCOPE_AGENT); }
__device__ __forceinline__ unsigned xb_xcc_id() { return (unsigned)__builtin_amdgcn_s_getreg((3 << 11) | 20) & 0xFu; }
#define XB_SPIN(cond, bar) do { unsigned _sp = 0; while (cond) { __builtin_amdgcn_s_sleep(1); \
    if ((++_sp & 255u) == 0u) { if (xb_ld(&(bar)[XB_TMO])) break; if (_sp > XB_SPIN_CAP) { atomicAdd(&(bar)[XB_TMO], 1u); break; } } } } while (0)

struct XcdBarrier {
    unsigned* bar; unsigned x;
    volatile LAS unsigned* st;
};

__device__ __forceinline__ XcdBarrier xcd_barrier_post(unsigned* bar, volatile LAS unsigned* st) {
    XcdBarrier b; b.bar = bar; b.x = xb_xcc_id(); b.st = st;
    if (threadIdx.x == 0) (void)xb_add(&bar[XB_XCNT(b.x)], 1u);
    return b;
}
__device__ __forceinline__ void xcd_barrier_complete(unsigned* bar, unsigned x, unsigned& nloc, unsigned& nx) {
    const unsigned G = gridDim.x * gridDim.y * gridDim.z;
    unsigned sum, cnt, mine, sp = 0u;
    for (;;) {
        sum = 0u; cnt = 0u; mine = 0u;
#pragma unroll
        for (unsigned j = 0; j < 16; ++j) { const unsigned c = xb_ld(&bar[XB_XCNT(j)]); sum += c; cnt += (c > 0u) ? 1u : 0u; mine = (j == x) ? c : mine; }
        if (sum == G) break;
        __builtin_amdgcn_s_sleep(1);
        if ((++sp & 255u) == 0u) { if (xb_ld(&bar[XB_TMO])) break; if (sp > XB_SPIN_CAP) { atomicAdd(&bar[XB_TMO], 1u); break; } }
    }
    nloc = mine > 0u ? mine : 1u; nx = cnt > 0u ? cnt : 1u;
}

__device__ __forceinline__ void xcd_barrier(const XcdBarrier& b) {
    asm volatile("s_waitcnt vmcnt(0)" ::: "memory");
    __syncthreads();
    if (threadIdx.x == 0) {
        unsigned* bar = b.bar;
        __builtin_amdgcn_s_waitcnt(0);
        unsigned nloc = b.st[0], nx = b.st[1];
        if (nloc == 0u) { xcd_barrier_complete(bar, b.x, nloc, nx); b.st[0] = nloc; b.st[1] = nx; }
        const unsigned old = xb_add(&bar[XB_XSUB(b.x)], 1u);
        const unsigned gen = old / nloc;
        if (old + 1u == (gen + 1u) * nloc) {
            __builtin_amdgcn_fence(__ATOMIC_RELEASE, "agent");
            asm volatile("s_waitcnt vmcnt(0)" ::: "memory");
            const unsigned og = xb_add(&bar[XB_TOP], 1u);
            const unsigned tg = og / nx;
            if (og + 1u == (tg + 1u) * nx) xb_add(&bar[XB_TOPGEN], 1u);
            else XB_SPIN(xb_ld(&bar[XB_TOPGEN]) == tg, bar);
            __builtin_amdgcn_fence(__ATOMIC_ACQUIRE, "agent");
            xb_add(&bar[XB_XGEN(b.x)], 1u);
            asm volatile("s_waitcnt vmcnt(0)" ::: "memory");
        } else {
            XB_SPIN(xb_ld(&bar[XB_XGEN(b.x)]) == gen, bar);
            __builtin_amdgcn_fence(__ATOMIC_ACQUIRE, "agent");
            asm volatile("s_waitcnt vmcnt(0)" ::: "memory");
        }
    }
    __syncthreads();
}

constexpr int NPHASES = 2 + 9 * DEPTH;
#define GRID_SYNC() xcd_barrier(bar)
template <int L>
__device__ __forceinline__ void layer_phases(LAS unsigned char* lds, const int W0, const XcdBarrier& bar) {
    constexpr int Mrows = (L == 0) ? MALL : MLAT;
    { const Params& P = *kparams(); unsigned char* ws = P.ws; const unsigned char* wl = ws + WS_W + (size_t)L * SZ_WL;
      EpiU E{(bf16_t*)(ws + WS_BIG), (const float*)(ws + WS_ROPE)}; run_gemm(lds, (const bf16_t*)(ws + WS_A), (const bf16_t*)wl, MALL, DIN, DM, E, W0); }
    GRID_SYNC();
    { const Params& P = *kparams(); phase_m1(P, lds, L, W0); }
#if DBG_DUPK & 2
    GRID_SYNC(); { const Params& P = *kparams(); phase_m1(P, lds, L, W0); }
#endif
    GRID_SYNC();
    { const Params& P = *kparams(); phase_m2(P, lds, L, 0, W0); }
#if DBG_DUPK & 4
    GRID_SYNC(); { const Params& P = *kparams(); phase_m2(P, lds, L, 1, W0); }
#endif
    GRID_SYNC();
    { const Params& P = *kparams(); phase_m3(P, lds, L, W0); }
#if DBG_DUPK & 8
    GRID_SYNC(); { const Params& P = *kparams(); phase_m3(P, lds, L, W0); }
#endif
    GRID_SYNC();
    { const Params& P = *kparams(); unsigned char* ws = P.ws; const unsigned char* wl = ws + WS_W + (size_t)L * SZ_WL;
      EpiPlain E{(bf16_t*)(ws + WS_BIG), DM, 0}; run_gemm(lds, (const bf16_t*)(ws + WS_MIX), (const bf16_t*)(wl + SZ_WIN), MLAT, DM, KOUT, E, W0);
      if (L == 0) { EpiPlain E2{(bf16_t*)(ws + WS_R2), DM, (size_t)512 * DM}; run_gemm_split(lds, (const bf16_t*)(ws + WS_MIX) + (size_t)MLAT * KOUT, (const bf16_t*)(wl + SZ_WIN), 512, DM, KOUT, 5, E2, W0); } }
    GRID_SYNC();
    { const Params& P = *kparams(); phase_rows(P, lds, 1, L, W0); }
    GRID_SYNC();
    { const Params& P = *kparams(); unsigned char* ws = P.ws; const unsigned char* wl = ws + WS_W + (size_t)L * SZ_WL;
      EpiSwiGLU E{(bf16_t*)(ws + WS_BIG), DFF}; run_gemm(lds, (const bf16_t*)(ws + WS_A), (const bf16_t*)(wl + SZ_WIN + SZ_WOUT), Mrows, 2 * DFF, DM, E, W0); }
    GRID_SYNC();
    { const Params& P = *kparams(); unsigned char* ws = P.ws; const unsigned char* wl = ws + WS_W + (size_t)L * SZ_WL;
      EpiPlain E{(bf16_t*)(ws + WS_R2), DM, 0}; run_gemm(lds, (const bf16_t*)(ws + WS_BIG), (const bf16_t*)(wl + SZ_WIN + SZ_WOUT + SZ_WFI), MLAT, DM, DFF, E, W0);
      if (L == 0) { EpiPlain E2{(bf16_t*)(ws + WS_MIX), DM, (size_t)512 * DM}; run_gemm_split(lds, (const bf16_t*)(ws + WS_BIG) + (size_t)MLAT * DFF, (const bf16_t*)(wl + SZ_WIN + SZ_WOUT + SZ_WFI), 512, DM, DFF, 11, E2, W0); } }
    GRID_SYNC();
    { const Params& P = *kparams(); phase_rows(P, lds, 2, L, W0); }
}

__global__ void __launch_bounds__(NTHREADS, 2) mega_fwd(Params P) {
    extern __shared__ __attribute__((aligned(16))) unsigned char smem[];
    LAS unsigned char* lds = (LAS unsigned char*)smem;
    const int W0 = __builtin_amdgcn_readfirstlane((int)threadIdx.x >> 6);
    volatile LAS unsigned* st = (volatile LAS unsigned*)(lds + LDS_BYTES - 64);
    if (threadIdx.x == 0) { st[0] = 0u; st[1] = 0u; }
    __syncthreads();
    const XcdBarrier bar = xcd_barrier_post((unsigned*)(P.ws + WS_CTL), st);
    phase0(P, lds, W0);
#if DBG_DUPK & 1
    GRID_SYNC(); phase0(P, lds, W0);
#endif
    __syncthreads(); cg::this_grid().sync();
    phase_rows(P, lds, 0, 0, W0);
#if DBG_DUPK & 16
    GRID_SYNC(); phase_rows(P, lds, 0, 0, W0);
#endif
    GRID_SYNC();
    layer_phases<0>(lds, W0, bar);
    GRID_SYNC();
    layer_phases<1>(lds, W0, bar);
}

#if DBG_NAIVE & 2
__global__ void __launch_bounds__(64) dbg_hgrn_naive(Params P, int l, int dir) {
    const int lane = threadIdx.x, b = blockIdx.x >> 2, h = blockIdx.x & 3;
    const bf16_t* U = (const bf16_t*)(P.ws + WS_BIG); bf16_t* MIX = (bf16_t*)(P.ws + WS_MIX);
    float* OF = (float*)(P.ws + WS_A + 16777216);
    const float lb = hgrn_lb(P, l, dir, h * 64 + lane);
    const int fcol = (dir == 0 ? C_FF : C_FB) + h * 64 + lane;
    float S[64];
#pragma unroll
    for (int j = 0; j < 64; ++j) S[j] = 0.f;
    for (int step = 0; step < NCTX + NSEQ; ++step) {
        int row; if (step < NCTX) row = MLAT + b * NCTX + (dir == 0 ? step : NCTX - 1 - step); else { const int s2 = step - NCTX; row = b * NSEQ + (dir == 0 ? s2 : NSEQ - 1 - s2); }
        const bf16_t* ur = U + (size_t)row * DIN;
        const float f = lb + (1.f - lb) * sigmoidf_(bf2f(ur[fcol])); const float q = siluf(bf2f(ur[C_QD + h * 64 + lane])); const float v = bf2f(ur[C_IV + h * 64 + lane]);
        float o = 0.f;
#pragma unroll
        for (int j = 0; j < 64; ++j) { const float fj = __shfl(f, j), qj = __shfl(q, j); S[j] = fj * (S[j] - v) + v; o += S[j] * qj; }
        float* op = OF + (size_t)row * 256 + h * 64 + lane;
        if (dir == 0) *op = o;
        else { const float val = *op + o; const float rstd = rsqrtf(wave_sum(val * val) * (1.f / 64.f) + EPS);
            const float gn = P.in[16][l * 256 + h * 64 + lane]; const float gz = bf2f(ur[C_GD + h * 64 + lane]);
            MIX[(size_t)row * KOUT + O_D + h * 64 + lane] = (bf16_t)f2bf(val * rstd * gn * siluf(gz)); }
    }
}
#endif

#if DBG_NAIVE & 56
__global__ void __launch_bounds__(256) dbg_gemm(const bf16_t* A, int K, const float* W, int ldw, int N, int emode, bf16_t* O, int ldo) {
    const int n = blockIdx.x * 256 + threadIdx.x, row0 = blockIdx.y * 16;
    float acc[16], acc2[16];
#pragma unroll
    for (int r = 0; r < 16; ++r) { acc[r] = 0.f; acc2[r] = 0.f; }
    for (int k8 = 0; k8 < K; k8 += 8) {
        float w[8], w2[8];
#pragma unroll
        for (int i = 0; i < 8; ++i) { w[i] = W[(size_t)(k8 + i) * ldw + n]; w2[i] = emode == 1 ? W[(size_t)(k8 + i) * ldw + N + n] : 0.f; }
#pragma unroll
        for (int r = 0; r < 16; ++r) { const bf16x8 a = *(const bf16x8*)(A + (size_t)(row0 + r) * K + k8);
#pragma unroll
            for (int i = 0; i < 8; ++i) { const float av = bf2f((unsigned short)a[i]); acc[r] += av * w[i]; if (emode == 1) acc2[r] += av * w2[i]; } }
    }
#pragma unroll
    for (int r = 0; r < 16; ++r) { const float v = emode == 1 ? siluf(acc[r]) * acc2[r] : acc[r]; O[(size_t)(row0 + r) * ldo + n] = (bf16_t)f2bf(v); }
}
#endif

#if DBG_NAIVE & 32
__global__ void dbg_fcs(const bf16_t* MIX, bf16_t* F, int M) {
    const int row = blockIdx.x, gm = threadIdx.x, g = gm >> 6, m = gm & 63; if (row >= M) return;
    float s = 0.f;
    for (int j = 0; j < 64; ++j) { float sn, cs; sincospif((float)((m * j) & 63) * (1.f / 32.f), &sn, &cs);
        s += bf2f(MIX[(size_t)row * KOUT + O_Z + g * 64 + j]) * cs + bf2f(MIX[(size_t)row * KOUT + O_Z + 256 + g * 64 + j]) * sn; }
    F[(size_t)row * 256 + gm] = (bf16_t)f2bf(s * 0.125f);
}
__global__ void dbg_cc(const bf16_t* MIX, bf16_t* CC, int M) {
    const int row = blockIdx.x, c = threadIdx.x; if (row >= M) return;
    CC[(size_t)row * 1024 + c] = MIX[(size_t)row * KOUT + O_A + c]; CC[(size_t)row * 1024 + 512 + c] = MIX[(size_t)row * KOUT + O_C + c]; CC[(size_t)row * 1024 + 768 + c] = MIX[(size_t)row * KOUT + O_D + c];
}
#endif
#ifdef DBG_STOP
__global__ void dbg_dump(float* out, const unsigned short* ws16, int n) {
    for (int i = blockIdx.x * blockDim.x + threadIdx.x; i < n; i += gridDim.x * blockDim.x) {
        const unsigned ob = __builtin_bit_cast(unsigned, out[i]); float s = (float)(ob >> 16) + (float)(ob & 0xffffu);
        for (int c = 0; c < 8; ++c) { const size_t idx = (size_t)i + (size_t)c * n; if (idx < WS_END / 2) s += (float)ws16[idx]; }
        out[i] = s; }
}
#endif
extern "C" void kernel_launch(void* const* d_in, const int* in_sizes, int n_in, void* d_out, int out_size, void* d_ws, size_t ws_size, hipStream_t stream) {
    static int grid = 0;
    if (grid == 0) {
        if (n_in != 19 || ws_size < WS_END) { fprintf(stderr, "kernel_launch: unexpected inputs (n_in %d, ws %zu, need %zu)\n", n_in, ws_size, (size_t)WS_END); grid = -1; return; }
        if (hipFuncSetAttribute((const void*)mega_fwd, hipFuncAttributeMaxDynamicSharedMemorySize, LDS_BYTES) != hipSuccess) { fprintf(stderr, "kernel_launch: hipFuncSetAttribute failed\n"); grid = -1; return; }
        int dev = 0, cus = 0, per_cu = 0;
        hipGetDevice(&dev); hipDeviceGetAttribute(&cus, hipDeviceAttributeMultiprocessorCount, dev);
        hipOccupancyMaxActiveBlocksPerMultiprocessor(&per_cu, (const void*)mega_fwd, NTHREADS, LDS_BYTES);
        if (per_cu < 1) { fprintf(stderr, "kernel_launch: occupancy query says %d blocks per CU\n", per_cu); per_cu = 1; }
        (void)hipGetLastError();
        grid = cus * per_cu;
        if (grid != 256) { fprintf(stderr, "kernel_launch: this kernel's phase programs are dealt for exactly 256 co-resident workgroups (256 CUs x 1); got %d; nothing launched\n", grid); grid = -1; return; }
    }
    if (grid < 0) return;
#ifdef DBG_MEMSET
    (void)hipMemsetAsync(d_ws, 0, WS_END, stream);
#endif
    if (hipMemsetAsync((char*)d_ws + WS_CTL, 0, CTL_BYTES, stream) != hipSuccess) { fprintf(stderr, "kernel_launch: memset of barrier words failed\n"); return; }
    Params p{};
    for (int i = 0; i < 19; ++i) p.in[i] = (const float*)d_in[i];
    p.out = (float*)d_out; p.ws = (unsigned char*)d_ws;
    p.ph_lo = 0; p.ph_hi = NPHASES;
    void* args[] = {&p};
    hipError_t e = hipLaunchCooperativeKernel((const void*)mega_fwd, dim3(grid), dim3(NTHREADS), args, LDS_BYTES, stream);
    if (e != hipSuccess) fprintf(stderr, "cooperative launch failed: %s (grid %d)\n", hipGetErrorString(e), grid);
}
```

```cpp
#include <hip/hip_runtime.h>
#include <hip/hip_cooperative_groups.h>
#include <cstdio>
#include <cstdint>
namespace cg = cooperative_groups;

#ifndef MK_SINGLE
#define MK_SINGLE 0
#ifndef DBG_ZERO
#define DBG_ZERO 0
#endif
#ifndef DBG_NPH
#define DBG_NPH 0
#endif
#ifndef DBG_ROWSEL
#define DBG_ROWSEL 0
#endif
#ifndef DBG_NAIVE
#define DBG_NAIVE 0
#endif
#ifndef DBG_DUP
#define DBG_DUP 0
#endif
#ifndef DBG_DUP2
#define DBG_DUP2 0
#endif
#ifndef DBG_DUPK
#define DBG_DUPK 0
#endif
#ifndef HG_BAR
#define HG_BAR 3
#endif
#ifndef DBG_SUB
#define DBG_SUB 15
#endif
#endif

__device__ __forceinline__ int opaque_tid(int w0) { int t; asm volatile("v_mbcnt_lo_u32_b32 %0, -1, 0\n\tv_mbcnt_hi_u32_b32 %0, -1, %0" : "=v"(t)); return w0 * 64 + t; }

namespace pg8 {
#define PG8_LAS __attribute__((address_space(3)))
typedef unsigned short bf16_t;
typedef short bf16x8 __attribute__((ext_vector_type(8)));
typedef float f32x4 __attribute__((ext_vector_type(4)));
typedef unsigned u32x4 __attribute__((ext_vector_type(4)));
constexpr int BM = 256, BK = 64, HALF = 128, HTB = HALF * BK * 2  , STAGE_BYTES = 8 * HTB, NXCD = 8, WGM = 8;

__host__ __device__ __forceinline__ int lds_byte(int r, int c) { const int st = (r >> 4) * 2 + (c >> 5), rr = r & 15, cc = c & 31, ob = rr * 64 + cc * 2; return st * 1024 + (ob ^ (((ob >> 9) & 1) << 5)); }
__host__ __device__ __forceinline__ void stage_rc(int b, int& R, int& C) { const int st = b / 1024, sb = b % 1024, swz = sb ^ (((sb >> 9) & 1) << 5); R = (st >> 1) * 16 + swz / 64; C = (st & 1) * 32 + (swz % 64) / 2; }
__host__ __device__ __forceinline__ int perm32(int rho) { const int n = rho >> 4, i = rho & 15; return 8 * (i >> 2) + 4 * n + (i & 3); }

struct Unit { int pm, pn, ks; };
struct Gemm { const bf16_t* A; const bf16_t* Bt; int M, N, K, ldk; };

struct StaticOrder {
    int nM, nN, nwg, G, c;
    __host__ __device__ void init(int M, int N, int G_, int c_) { nM = M / BM; nN = N / BM; nwg = nM * nN; G = G_; c = c_; }
    __host__ __device__ bool next(int i, Unit& u) const {
        const long L = (long)i * G + c; if (L >= nwg) return false;
        int wgid = (int)L; { const int q = nwg / NXCD, r = nwg % NXCD, xcd = wgid % NXCD, off = wgid / NXCD; wgid = (xcd < r ? xcd * (q + 1) : r * (q + 1) + (xcd - r) * q) + off; }
        const int nig = WGM * nN, gid = wgid / nig, fm = gid * WGM, gsz = (nM - fm) < WGM ? (nM - fm) : WGM;
        u.pm = fm + ((wgid % nig) % gsz); u.pn = (wgid % nig) / gsz; u.ks = 0; return true;
    }
    __device__ __forceinline__ void a_ready(const Unit&) const {}
    __device__ __forceinline__ void done(const Unit&) const {}
};

__device__ __forceinline__ unsigned cvt_pk_bf16(float lo, float hi) { unsigned r; asm volatile("v_cvt_pk_bf16_f32 %0, %1, %2" : "=v"(r) : "v"(lo), "v"(hi)); return r; }
template <class Epi, class Sched, bool ALIGN_EPI = false, bool SP2 = false>
__device__ __forceinline__ void gemm_phase(PG8_LAS unsigned char* lds, const Gemm g, const Sched& S, const Epi& E, const int W0) {
    const int tid = opaque_tid(W0), wid = __builtin_amdgcn_readfirstlane(tid >> 6), lane = tid & 63, wr = wid >> 2, wc = wid & 3, fr = lane & 15, fq = lane >> 4;
    const int K = g.ldk, nt = g.K / BK;
    const size_t sstep = (size_t)g.K * 2;
    unsigned voffA[2], voffB[2];
#pragma unroll
    for (int i = 0; i < 2; ++i) { int R, C; stage_rc(tid * 16 + i * 8192, R, C); const int Rb = Epi::PERM ? ((R & ~31) + perm32(R & 31)) : R;
        voffA[i] = (unsigned)(R * K + C) * 2u; voffB[i] = (unsigned)(Rb * K + C) * 2u; }
    const size_t kstep = (size_t)(BK * 2);
    const size_t hstep = (size_t)HALF * K * 2;
    const size_t tstep = 2 * hstep;
    const unsigned ldsw = (unsigned)wid * 1024u;
    const int aoff = lds_byte(wr * 64 + fr, fq * 8), boff = lds_byte(wc * 32 + fr, fq * 8);
#define PG8_SA(b, h) (((b) * 2 + (h)) * HTB)
#define PG8_SB(b, h) ((4 + (b) * 2 + (h)) * HTB)
#define PG8_STAGE(bufoff, gbase, voff) do { _Pragma("unroll") for (int _i = 0; _i < 2; ++_i) \
        __builtin_amdgcn_global_load_lds((const unsigned*)((const char*)(gbase) + (voff)[_i]), (PG8_LAS unsigned*)(lds + (bufoff) + ldsw + _i * 8192), 16, 0, 0); } while (0)
#define PG8_LDA(dst, b, h) do { _Pragma("unroll") for (int m = 0; m < 4; ++m) _Pragma("unroll") for (int k = 0; k < 2; ++k) dst[m][k] = *(const PG8_LAS bf16x8*)(lds + PG8_SA(b, h) + aoff + m * 2048 + k * 1024); } while (0)
#define PG8_LDB(dst, b, h) do { _Pragma("unroll") for (int n = 0; n < 2; ++n) _Pragma("unroll") for (int k = 0; k < 2; ++k) dst[n][k] = *(const PG8_LAS bf16x8*)(lds + PG8_SB(b, h) + boff + n * 2048 + k * 1024); } while (0)
#define PG8_MMA(ai, bj, At, Bt) do { __builtin_amdgcn_s_setprio(1); _Pragma("unroll") for (int m = 0; m < 4; ++m) _Pragma("unroll") for (int n = 0; n < 2; ++n) _Pragma("unroll") for (int k = 0; k < 2; ++k) \
        acc[ai][bj][m][n] = __builtin_amdgcn_mfma_f32_16x16x32_bf16(Bt[n][k], At[m][k], acc[ai][bj][m][n], 0, 0, 0); __builtin_amdgcn_s_setprio(0); } while (0)
#define PG8_WAIT_V(n) asm volatile("s_waitcnt vmcnt(" #n ")" ::: "memory")
#define PG8_WAIT_L(n) asm volatile("s_waitcnt lgkmcnt(" #n ")" ::: "memory")
#define PG8_BAR __builtin_amdgcn_s_barrier()
#define PG8_SCHED __builtin_amdgcn_sched_barrier(0)
    Unit cur, nxt; int ui = 0;
    if (!S.next(0, cur)) return;
    f32x4 acc[2][2][4][2];
#pragma unroll
    for (int a = 0; a < 2; ++a)
#pragma unroll
        for (int b = 0; b < 2; ++b)
#pragma unroll
            for (int m = 0; m < 4; ++m)
#pragma unroll
                for (int n = 0; n < 2; ++n) acc[a][b][m][n] = (f32x4){0.f, 0.f, 0.f, 0.f};
    bf16x8 At[4][2], B0[2][2], B1[2][2];
    const char* cA = (const char*)g.A + (size_t)cur.pm * tstep + (size_t)cur.ks * sstep; const char* cB = (const char*)g.Bt + (size_t)cur.pn * tstep + (size_t)cur.ks * sstep;
    S.a_ready(cur);
    if constexpr (SP2) {
        PG8_STAGE(PG8_SB(0, 0), cB, voffB); PG8_STAGE(PG8_SB(0, 1), cB + hstep, voffB); PG8_STAGE(PG8_SA(0, 0), cA, voffA); PG8_STAGE(PG8_SA(0, 1), cA + hstep, voffA);
        if (wr == 1) PG8_BAR;
        PG8_WAIT_V(2); PG8_BAR;
        PG8_STAGE(PG8_SB(1, 0), cB + kstep, voffB); PG8_STAGE(PG8_SA(1, 0), cA + kstep, voffA); PG8_STAGE(PG8_SB(1, 1), cB + hstep + kstep, voffB);
        PG8_WAIT_V(6); PG8_BAR;
    } else {
        PG8_STAGE(PG8_SB(0, 0), cB, voffB); PG8_STAGE(PG8_SA(0, 0), cA, voffA); PG8_STAGE(PG8_SB(0, 1), cB + hstep, voffB); PG8_STAGE(PG8_SA(0, 1), cA + hstep, voffA);
        if (wr == 1) PG8_BAR;
        PG8_WAIT_V(4); PG8_BAR;
        PG8_STAGE(PG8_SB(1, 0), cB + kstep, voffB); PG8_STAGE(PG8_SA(1, 0), cA + kstep, voffA); PG8_STAGE(PG8_SB(1, 1), cB + hstep + kstep, voffB);
        PG8_WAIT_V(6); PG8_BAR;
    }
    for (;;) {
        const bool has_next = S.next(ui + 1, nxt);
        const char* nA = has_next ? (const char*)g.A + (size_t)nxt.pm * tstep + (size_t)nxt.ks * sstep : cA; const char* nB = has_next ? (const char*)g.Bt + (size_t)nxt.pn * tstep + (size_t)nxt.ks * sstep : cB;
        for (int t = 0; t < nt; t += 2) {
            const bool last = (t == nt - 2);
            const char* a1 = cA + (size_t)(t + 1) * kstep;
            const char* a2 = last ? nA : cA + (size_t)(t + 2) * kstep; const char* b2 = last ? nB : cB + (size_t)(t + 2) * kstep;
            const char* a3 = a2 + kstep; const char* b3 = b2 + kstep;
            if (last && has_next) S.a_ready(nxt);
            if constexpr (SP2) {
            PG8_LDB(B0, 0, 0); PG8_LDB(B1, 0, 1); PG8_SCHED; PG8_LDA(At, 0, 0); PG8_STAGE(PG8_SA(1, 1), a1 + hstep, voffA);
            PG8_WAIT_V(8); PG8_WAIT_L(0); PG8_BAR; PG8_MMA(0, 0, At, B0); PG8_MMA(0, 1, At, B1); PG8_BAR; PG8_SCHED;
            PG8_LDA(At, 0, 1); PG8_STAGE(PG8_SB(0, 0), b2, voffB); PG8_STAGE(PG8_SB(0, 1), b2 + hstep, voffB); PG8_STAGE(PG8_SA(0, 0), a2, voffA);
            PG8_WAIT_V(8); PG8_WAIT_L(0); PG8_BAR; PG8_MMA(1, 0, At, B0); PG8_MMA(1, 1, At, B1); PG8_BAR; PG8_SCHED;
            PG8_LDB(B0, 1, 0); PG8_LDB(B1, 1, 1); PG8_SCHED; PG8_LDA(At, 1, 0); PG8_STAGE(PG8_SA(0, 1), a2 + hstep, voffA);
            PG8_WAIT_V(8); PG8_WAIT_L(0); PG8_BAR; PG8_MMA(0, 0, At, B0); PG8_MMA(0, 1, At, B1); PG8_BAR; PG8_SCHED;
            PG8_LDA(At, 1, 1); PG8_STAGE(PG8_SB(1, 0), b3, voffB); PG8_STAGE(PG8_SB(1, 1), b3 + hstep, voffB); PG8_STAGE(PG8_SA(1, 0), a3, voffA);
            PG8_WAIT_V(8); PG8_WAIT_L(0); PG8_BAR; PG8_MMA(1, 0, At, B0); PG8_MMA(1, 1, At, B1); PG8_BAR; PG8_SCHED;
            } else {
            PG8_LDB(B0, 0, 0); PG8_SCHED; PG8_LDA(At, 0, 0); PG8_STAGE(PG8_SA(1, 1), a1 + hstep, voffA);
            PG8_WAIT_L(8); PG8_BAR; PG8_WAIT_L(0); PG8_MMA(0, 0, At, B0); PG8_BAR; PG8_SCHED;
            PG8_LDB(B1, 0, 1); PG8_STAGE(PG8_SB(0, 0), b2, voffB);
            PG8_BAR; PG8_WAIT_L(0); PG8_MMA(0, 1, At, B1); PG8_BAR;
            PG8_LDA(At, 0, 1); PG8_STAGE(PG8_SA(0, 0), a2, voffA);
            PG8_BAR; PG8_WAIT_L(0); PG8_MMA(1, 0, At, B0); PG8_BAR; PG8_SCHED;
            PG8_STAGE(PG8_SB(0, 1), b2 + hstep, voffB);
            PG8_WAIT_V(6); PG8_BAR; PG8_MMA(1, 1, At, B1); PG8_BAR;
            PG8_LDB(B0, 1, 0); PG8_SCHED; PG8_LDA(At, 1, 0); PG8_STAGE(PG8_SA(0, 1), a2 + hstep, voffA);
            PG8_WAIT_L(8); PG8_BAR; PG8_WAIT_L(0); PG8_MMA(0, 0, At, B0); PG8_BAR; PG8_SCHED;
            PG8_LDB(B1, 1, 1); PG8_STAGE(PG8_SB(1, 0), b3, voffB);
            PG8_BAR; PG8_WAIT_L(0); PG8_MMA(0, 1, At, B1); PG8_BAR;
            PG8_LDA(At, 1, 1); PG8_STAGE(PG8_SA(1, 0), a3, voffA);
            PG8_BAR; PG8_WAIT_L(0); PG8_MMA(1, 0, At, B0); PG8_BAR; PG8_SCHED;
            PG8_STAGE(PG8_SB(1, 1), b3 + hstep, voffB);
            PG8_WAIT_V(6); PG8_BAR; PG8_MMA(1, 1, At, B1); PG8_BAR;
            }
        }
        if constexpr (ALIGN_EPI) { if (wr == 0) PG8_BAR; }
        if constexpr (!Epi::AFTER_DRAIN) { E(acc, cur, wr, wc, fr, fq); S.done(cur); }
        if (!has_next) break;
#pragma unroll
        for (int a = 0; a < 2; ++a)
#pragma unroll
            for (int b = 0; b < 2; ++b)
#pragma unroll
                for (int m = 0; m < 4; ++m)
#pragma unroll
                    for (int n = 0; n < 2; ++n) acc[a][b][m][n] = (f32x4){0.f, 0.f, 0.f, 0.f};
        cur = nxt; cA = nA; cB = nB; ++ui;
        if constexpr (ALIGN_EPI) { if (wr == 1) PG8_BAR; }
    }
    PG8_WAIT_V(0);
    if constexpr (!ALIGN_EPI) { if (wr == 0) PG8_BAR; }
    PG8_BAR;
    if constexpr (Epi::AFTER_DRAIN) { E.fused(acc, cur, wr, wc, fr, fq, lds, wid, lane); S.done(cur); }
#undef PG8_SA
#undef PG8_SB
#undef PG8_STAGE
#undef PG8_LDA
#undef PG8_LDB
#undef PG8_MMA
#undef PG8_WAIT_V
#undef PG8_WAIT_L
#undef PG8_BAR
#undef PG8_SCHED
}
}

namespace pg8 {
struct SplitOrder {
    int nN, S, nwg, G, c;
    __host__ __device__ void init(int M, int N, int S_, int G_, int c_) { nN = N / BM; S = S_; nwg = (M / BM) * nN * S; G = G_; c = c_; }
    __host__ __device__ bool next(int i, Unit& u) const { const long L = (long)i * G + c; if (L >= nwg) return false; const int l = (int)L; u.ks = l % S; u.pn = (l / S) % nN; u.pm = l / (S * nN); return true; }
    __device__ __forceinline__ void a_ready(const Unit&) const {}
    __device__ __forceinline__ void done(const Unit&) const {}
};
}
#define LAS __attribute__((address_space(3)))
typedef unsigned short bf16_t;
typedef short bf16x8 __attribute__((ext_vector_type(8)));
typedef float f32x4 __attribute__((ext_vector_type(4)));
typedef unsigned u32x4 __attribute__((ext_vector_type(4)));
typedef unsigned u32x2 __attribute__((ext_vector_type(2)));

constexpr int NBATCH = 2, NSEQ = 8192, DM = 1024, NCTX = 256, DEPTH = 2;
constexpr int MLAT = NBATCH * NSEQ;
constexpr int MALL = MLAT + NBATCH * NCTX;
constexpr int DIN = 2816, DFF = 2816, KOUT = 1280;
constexpr float EPS = 1e-6f;
constexpr int C_QA = 0, C_KA = 256, C_VA = 512, C_UB = 768, C_QS = 1024, C_KS = 1280, C_VS = 1408, C_QD = 1536, C_FF = 1792, C_FB = 2048, C_IV = 2304, C_GD = 2560;
constexpr int O_A = 0, O_C = 256, O_D = 512, O_Z = 768;
constexpr int NCHUNK = 132;

constexpr size_t SZ_WIN = (size_t)DIN * DM * 2, SZ_WOUT = (size_t)DM * KOUT * 2, SZ_WFI = (size_t)2 * DFF * DM * 2, SZ_WFO = (size_t)DM * DFF * 2;
constexpr size_t SZ_WL = SZ_WIN + SZ_WOUT + SZ_WFI + SZ_WFO;
constexpr size_t WS_W = 0;
constexpr size_t WS_A = WS_W + 2 * SZ_WL;
constexpr size_t WS_MIX = WS_A + (size_t)MALL * DM * 2;
constexpr size_t WS_BIG = WS_MIX + (size_t)MALL * KOUT * 2;
constexpr size_t WS_R2 = WS_BIG + (size_t)MALL * DIN * 2;
constexpr size_t WS_MISC = WS_R2 + (size_t)MALL * DM * 2;
constexpr size_t WS_ADAP = WS_MISC;
constexpr size_t WS_HCTX = WS_ADAP + (size_t)2 * 8 * 3 * 6144 * 4;
constexpr size_t WS_HD = WS_HCTX + (size_t)512 * 1024 * 4;
constexpr size_t WS_TA = WS_HD + (size_t)16 * NCHUNK * 64 * 4;
constexpr size_t WS_TC = WS_TA + 128 * 64 * 2;
constexpr size_t WS_TCTX = WS_TC + 256 * 256 * 2;
constexpr size_t WS_ROPE = WS_TCTX + 512 * 256 * 2;
constexpr size_t WS_ADAF = WS_ROPE + 128 * 16 * 8;
constexpr size_t WS_CTL = WS_ADAF + (size_t)2 * 3 * 6144 * 4;
constexpr size_t CTL_BYTES = 16384;
constexpr size_t WS_END = WS_CTL + CTL_BYTES;
static_assert(WS_END <= 268435456, "workspace map exceeds 256 MiB");
static_assert((size_t)16 * NCHUNK * 4096 * 4 <= (size_t)MALL * DM * 2, "HGRN states fit R2");

constexpr int LDS_BYTES = 147456;
constexpr int NTHREADS = 512, NWAVES = 8;

struct Params {
    const float* in[19];
    float* out;
    unsigned char* ws;
    int ph_lo, ph_hi;
};

__device__ __forceinline__ const Params* kparams() {
    unsigned long long p = (unsigned long long)__builtin_amdgcn_kernarg_segment_ptr(); asm volatile("" : "+s"(p)); return (const Params*)(const __attribute__((address_space(4))) void*)p; }
__device__ __forceinline__ unsigned f2bf(float f) { unsigned u = __builtin_bit_cast(unsigned, f); return (u + 0x7fffu + ((u >> 16) & 1u)) >> 16; }
typedef float f32x2_t __attribute__((ext_vector_type(2)));
typedef __bf16 bf16x2_t __attribute__((ext_vector_type(2)));
__device__ __forceinline__ unsigned pk2(float lo, float hi) { f32x2_t v = {lo, hi}; bf16x2_t b = __builtin_convertvector(v, bf16x2_t); return __builtin_bit_cast(unsigned, b); }
__device__ __forceinline__ float bf2f(unsigned short h) { return __builtin_bit_cast(float, (unsigned)h << 16); }
__device__ __forceinline__ float bflo(unsigned w) { return __builtin_bit_cast(float, w << 16); }
__device__ __forceinline__ float bfhi(unsigned w) { return __builtin_bit_cast(float, w & 0xffff0000u); }
__device__ __forceinline__ float wave_sum(float v) {
#pragma unroll
    for (int o = 1; o < 64; o <<= 1) v += __shfl_xor(v, o);
    return v;
}
__device__ __forceinline__ float siluf(float a) { return a / (1.f + __expf(-a)); }
__device__ __forceinline__ float sigmoidf_(float a) { return 1.f / (1.f + __expf(-a)); }

struct EpiPlain {
    static constexpr bool PERM = true, AFTER_DRAIN = false;
    bf16_t* O; int ldc; size_t pstride;
    __device__ __forceinline__ void operator()(const f32x4 (&acc)[2][2][4][2], const pg8::Unit& u, int wr, int wc, int fr, int fq) const {
        const int row0 = u.pm * 256 + wr * 64 + fr, col0 = u.pn * 256 + wc * 32 + 8 * fq;
#pragma unroll
        for (int ai = 0; ai < 2; ++ai)
#pragma unroll
            for (int m = 0; m < 4; ++m) { bf16_t* rowp = O + (size_t)u.ks * pstride + (size_t)(row0 + ai * 128 + m * 16) * ldc + col0;
#pragma unroll
                for (int bj = 0; bj < 2; ++bj) { const f32x4 v0 = acc[ai][bj][m][0], v1 = acc[ai][bj][m][1];
                    u32x4 w; w.x = pk2(v0[0], v0[1]); w.y = pk2(v0[2], v0[3]); w.z = pk2(v1[0], v1[1]); w.w = pk2(v1[2], v1[3]);
                    *(u32x4*)(rowp + bj * 128) = w; } }
    }
};
struct EpiSwiGLU {
    static constexpr bool PERM = true, AFTER_DRAIN = false;
    bf16_t* O; int ldc;
    __device__ __forceinline__ void operator()(const f32x4 (&acc)[2][2][4][2], const pg8::Unit& u, int wr, int wc, int fr, int fq) const {
        const int row0 = u.pm * 256 + wr * 64 + fr, col0 = u.pn * 128 + wc * 32 + 8 * fq;
#pragma unroll
        for (int ai = 0; ai < 2; ++ai)
#pragma unroll
            for (int m = 0; m < 4; ++m) { bf16_t* rowp = O + (size_t)(row0 + ai * 128 + m * 16) * ldc + col0;
                float h[8];
#pragma unroll
                for (int n = 0; n < 2; ++n)
#pragma unroll
                    for (int j = 0; j < 4; ++j) { const float a = acc[ai][0][m][n][j], g = acc[ai][1][m][n][j]; h[n * 4 + j] = a * __builtin_amdgcn_rcpf(1.f + __expf(-a)) * g; }
                u32x4 w; w.x = pk2(h[0], h[1]); w.y = pk2(h[2], h[3]); w.z = pk2(h[4], h[5]); w.w = pk2(h[6], h[7]);
                *(u32x4*)rowp = w; }
    }
};
struct EpiU {
    static constexpr bool PERM = false, AFTER_DRAIN = false;
    bf16_t* O; const float* rope;
    __device__ __forceinline__ void operator()(const f32x4 (&acc)[2][2][4][2], const pg8::Unit& u, int wr, int wc, int fr, int fq) const {
        const int row0 = u.pm * 256 + wr * 64 + fr, col0 = u.pn * 256 + wc * 32 + 4 * fq;
        const bool lat = (u.pm < 64);
#pragma unroll
        for (int ai = 0; ai < 2; ++ai)
#pragma unroll
            for (int m = 0; m < 4; ++m) { const int row = row0 + ai * 128 + m * 16; bf16_t* rowp = O + (size_t)row * DIN + col0;
                const int t = row & (NSEQ - 1); const int pos = (wc & 1) ? (t & 63) : (t >> 6);
                f32x4 cs0 = {1.f, 0.f, 1.f, 0.f}, cs1 = {1.f, 0.f, 1.f, 0.f};
                const bool anyrope = lat && (u.pn == 4 || u.pn == 5);
                if (anyrope) { const f32x4* rp = (const f32x4*)(rope + (size_t)(pos * 16 + 4 * fq) * 2); cs0 = rp[0]; cs1 = rp[1]; }
#pragma unroll
                for (int bj = 0; bj < 2; ++bj) { f32x4 v0 = acc[ai][bj][m][0], v1 = acc[ai][bj][m][1];
                    if (anyrope && (u.pn == 4 || bj == 0)) {
                        const float c[4] = {cs0[0], cs0[2], cs1[0], cs1[2]}, s[4] = {cs0[1], cs0[3], cs1[1], cs1[3]};
#pragma unroll
                        for (int j = 0; j < 4; ++j) { const float x1 = v0[j], x2 = v1[j]; v0[j] = x1 * c[j] - x2 * s[j]; v1[j] = x1 * s[j] + x2 * c[j]; }
                    }
                    u32x2 w0, w1; w0.x = pk2(v0[0], v0[1]); w0.y = pk2(v0[2], v0[3]); w1.x = pk2(v1[0], v1[1]); w1.y = pk2(v1[2], v1[3]);
                    *(u32x2*)(rowp + bj * 128) = w0; *(u32x2*)(rowp + bj * 128 + 16) = w1; } }
    }
};

__device__ __forceinline__ void transpose_tile(const float* W, int N, int k0s, int n0s, bf16_t* WT, int ldk, int n0d, int k0d, LAS float* scr, int tid) {
    { const int kk = tid >> 3, c8 = (tid & 7) * 8; const float* src = W + (size_t)(k0s + kk) * N + n0s + c8;
      const f32x4 a = *(const f32x4*)src, b = *(const f32x4*)(src + 4);
#pragma unroll
      for (int e = 0; e < 4; ++e) { scr[(c8 + e) * 65 + kk] = a[e]; scr[(c8 + 4 + e) * 65 + kk] = b[e]; } }
    __syncthreads();
    { const int nn = tid >> 3, k8 = (tid & 7) * 8; const LAS float* s = scr + nn * 65 + k8;
      u32x4 o; o.x = pk2(s[0], s[1]); o.y = pk2(s[2], s[3]); o.z = pk2(s[4], s[5]); o.w = pk2(s[6], s[7]);
      *(u32x4*)(WT + (size_t)(n0d + nn) * ldk + k0d + k8) = o; }
    __syncthreads();
}

__device__ __forceinline__ void phase0(const Params& P_, LAS unsigned char* lds, int W0) {
    const Params& P = *kparams();
    const int tid = opaque_tid(W0), G = gridDim.x, bid = blockIdx.x;
    unsigned char* ws = P.ws;
    LAS float* scr = (LAS float*)lds;
    constexpr int T_IN = 16 * 44, T_OUT = 12 * 16, T_FI = 16 * 88, T_FO = 44 * 16, T_L = T_IN + T_OUT + T_FI + T_FO;
    constexpr int N_TR = 2 * T_L, N_ADA = 2 * 24 * 8, N_M2 = 2 * 4 * 16, N_TAB = 64;
    constexpr int N_ALL = N_TR + N_ADA + N_M2 + N_TAB;
    for (int it = bid; it < N_ALL; it += G) {
        if (it < N_TR) {
            const int l = it / T_L; int r = it % T_L;
            bf16_t* wl = (bf16_t*)(ws + WS_W + (size_t)l * SZ_WL);
            if (r < T_IN) { const int kt = r / 44, nt = r % 44; transpose_tile(P.in[10] + (size_t)l * DM * DIN, DIN, kt * 64, nt * 64, wl, DM, nt * 64, kt * 64, scr, tid); continue; } r -= T_IN;
            if (r < T_OUT) { const int ktd = r / 16, nt = r % 16; const int kts = ktd < 4 ? ktd : ktd + 4;
                transpose_tile(P.in[11] + (size_t)l * DM * DM, DM, kts * 64, nt * 64, (bf16_t*)((unsigned char*)wl + SZ_WIN), KOUT, nt * 64, ktd * 64, scr, tid); continue; } r -= T_OUT;
            if (r < T_FI) { const int kt = r / 88, ntd = r % 88; const int pn = ntd >> 2, bj = (ntd >> 1) & 1, hf = ntd & 1; const int n0s = bj * DFF + pn * 128 + hf * 64;
                transpose_tile(P.in[17] + (size_t)l * DM * 2 * DFF, 2 * DFF, kt * 64, n0s, (bf16_t*)((unsigned char*)wl + SZ_WIN + SZ_WOUT), DM, ntd * 64, kt * 64, scr, tid); continue; } r -= T_FI;
            { const int kt = r / 16, nt = r % 16; transpose_tile(P.in[18] + (size_t)l * DFF * DM, DM, kt * 64, nt * 64, (bf16_t*)((unsigned char*)wl + SZ_WIN + SZ_WOUT + SZ_WFI), DFF, nt * 64, kt * 64, scr, tid); }
            continue;
        }
        int r = it - N_TR;
        if (r < N_ADA) {
            const int l = r / 192, jc = (r % 192) / 8, kc = r % 8;
            LAS float* sv = scr;
            LAS float* red = scr + 384;
            if (tid < 384) { const int v = tid >> 7, k = tid & 127; const float cv = (v < 2) ? P.in[1][v * DM + kc * 128 + k] : P.in[3][kc * 128 + k]; sv[tid] = siluf(cv); }
            __syncthreads();
            const int col = jc * 256 + (tid & 255), kh = tid >> 8;
            const float* w = P.in[4] + (size_t)l * DM * 6144 + (size_t)(kc * 128 + kh * 64) * 6144 + col;
            float a0 = 0.f, a1 = 0.f, a2 = 0.f;
#pragma unroll 8
            for (int k = 0; k < 64; ++k) { const float wv = w[(size_t)k * 6144]; a0 += sv[kh * 64 + k] * wv; a1 += sv[128 + kh * 64 + k] * wv; a2 += sv[256 + kh * 64 + k] * wv; }
            if (kh == 1) { red[(tid & 255) * 3 + 0] = a0; red[(tid & 255) * 3 + 1] = a1; red[(tid & 255) * 3 + 2] = a2; }
            __syncthreads();
            if (kh == 0) { float* dst = (float*)(ws + WS_ADAP) + (size_t)((l * 8 + kc) * 3) * 6144 + col;
                dst[0] = a0 + red[tid * 3 + 0]; dst[6144] = a1 + red[tid * 3 + 1]; dst[2 * 6144] = a2 + red[tid * 3 + 2]; }
            __syncthreads();
            continue;
        }
        r -= N_ADA;
        if (r < N_M2) {
            const int l = r / 64, g = (r % 64) / 16, nt = r % 16;
            const float* wf = P.in[13] + (size_t)l * 256 * 256 + (size_t)g * 64 * 256;
            const float* wo = P.in[11] + (size_t)l * DM * DM + (size_t)256 * DM + nt * 64;
            LAS float* wfs = scr;
            LAS float* wos = scr + 64 * 132;
            LAS float* Pm = wos + 128 * 64;
            LAS float* cst = Pm + 4096;
            const int n = tid & 63, mg = tid >> 6;
            float acc[8];
#pragma unroll
            for (int i = 0; i < 8; ++i) acc[i] = 0.f;
            for (int h2 = 0; h2 < 2; ++h2) {
#pragma unroll
                for (int k = 0; k < 16; ++k) { const int idx = tid + k * NTHREADS; { const int r_ = idx >> 7, c_ = idx & 127; wfs[r_ * 132 + c_] = wf[(size_t)r_ * 256 + h2 * 128 + c_]; }
                                               { const int r_ = idx >> 6, c_ = idx & 63; wos[r_ * 64 + c_] = wo[(size_t)(h2 * 128 + r_) * DM + c_]; } }
                __syncthreads();
                for (int q = 0; q < 128; q += 4) { const float w0 = wos[(q + 0) * 64 + n], w1 = wos[(q + 1) * 64 + n], w2 = wos[(q + 2) * 64 + n], w3 = wos[(q + 3) * 64 + n];
#pragma unroll
                    for (int i = 0; i < 8; ++i) { const f32x4 f4 = *(const LAS f32x4*)(wfs + (mg * 8 + i) * 132 + q); acc[i] += (f4[0] * w0 + f4[1] * w1) + (f4[2] * w2 + f4[3] * w3); } }
                __syncthreads();
            }
#pragma unroll
            for (int i = 0; i < 8; ++i) Pm[(mg * 8 + i) * 64 + n] = acc[i];
            if (tid < 64) cst[tid] = cospif((float)tid * (1.f / 32.f));
            __syncthreads();
            bf16_t* wot = (bf16_t*)(ws + WS_W + (size_t)l * SZ_WL + SZ_WIN);
            for (int rr = mg; rr < 128; rr += 8) { const int p = rr >> 6, j = rr & 63; float s = 0.f;
                for (int m = 0; m < 64; ++m) { const int a = (m * j) & 63; const float cs = p ? cst[(a + 48) & 63] : cst[a];
                    s += cs * Pm[m * 64 + n]; }
                wot[(size_t)(nt * 64 + n) * KOUT + 768 + p * 256 + g * 64 + j] = (bf16_t)f2bf(s * 0.125f); }
            __syncthreads();
            continue;
        }
        r -= N_M2;
        {
            const int NT = 64 * 512; const int gi = r * 512 + tid;
            bf16_t* TA = (bf16_t*)(ws + WS_TA); bf16_t* TC = (bf16_t*)(ws + WS_TC); bf16_t* TX = (bf16_t*)(ws + WS_TCTX); float* RP = (float*)(ws + WS_ROPE);
            for (int i = gi; i < 128 * 64; i += NT) { const int rr = i >> 6, t = i & 63; const int a = ((rr & 63) * t) & 63; float s, c; sincospif((float)a * (1.f / 32.f), &s, &c); TA[i] = (bf16_t)f2bf(rr < 64 ? c : -s); }
            for (int i = gi; i < 256 * 256; i += NT) { const int rr = i >> 8, cc = i & 255; const int p = rr >> 7, k2 = rr & 127, pp = cc >> 7, t2 = cc & 127; const int a = (k2 * t2) & 127;
                float s, c; sincospif((float)a * (1.f / 64.f), &s, &c); const float sc = 0.011048543456039806f;
                const float v = (p == 0) ? (pp == 0 ? c : s) : (pp == 0 ? -s : c); TC[i] = (bf16_t)f2bf(v * sc); }
            for (int i = gi; i < 512 * 256; i += NT) { const int rr = i >> 8, t = i & 255; const int p = rr >> 8, k = rr & 255; const int a = (k * t) & 255;
                float s, c; sincospif((float)a * (1.f / 128.f), &s, &c); TX[i] = (bf16_t)f2bf((p == 0 ? c : -s) * 0.0625f); }
            for (int i = gi; i < 128 * 16; i += NT) { const int pos = i >> 4, fi = i & 15; const float fr = powf(10000.f, -(float)fi * (1.f / 16.f)); const float ang = (float)pos * fr;
                RP[2 * i] = cosf(ang); RP[2 * i + 1] = sinf(ang); }
        }
    }
}

__device__ __forceinline__ float ada_value(const Params& P, int l, int v, int col) {
    const float* adap = (const float*)(P.ws + WS_ADAP); float s = P.in[5][l * 6144 + col];
#pragma unroll
    for (int kc = 0; kc < 8; ++kc) s += adap[(size_t)((l * 8 + kc) * 3 + v) * 6144 + col];
    return s;
}
template <bool FINAL>
__device__ __forceinline__ void load_mod(LAS float* dst, const Params& P, int l, int kind, int tid) {
    const float* adaf = (const float*)(P.ws + WS_ADAF);
    for (int i = tid; i < 3 * 1024; i += NTHREADS) { const int v = i >> 10, j = i & 1023, col = kind * 1024 + j;
        dst[i] = FINAL ? adaf[(size_t)(l * 3 + v) * 6144 + col] : ada_value(P, l, v, col); }
}
struct RowIn { f32x4 x[4]; u32x2 d[4]; };
__device__ __forceinline__ void row_load(RowIn& r, const float* xin, const bf16_t* delta, int lane) {
#pragma unroll
    for (int i = 0; i < 4; ++i) { r.x[i] = *(const f32x4*)(xin + lane * 4 + 256 * i); r.d[i] = delta ? *(const u32x2*)(delta + lane * 4 + 256 * i) : (u32x2){0u, 0u}; }
}
__device__ __forceinline__ void row_pass(const RowIn& rin, const bf16_t* delta, int npart, size_t pstride, const float* gpost, const LAS float* gt, float* xout,
                                         const float* gpre, const LAS float* sc, const LAS float* sh, bf16_t* aout, int lane) {
    f32x4 x[4];
#pragma unroll
    for (int i = 0; i < 4; ++i) x[i] = rin.x[i];
    if (delta) {
        f32x4 d[4]; float ss = 0.f;
#pragma unroll
        for (int i = 0; i < 4; ++i) { const u32x2 w = rin.d[i]; d[i] = (f32x4){bflo(w.x), bfhi(w.x), bflo(w.y), bfhi(w.y)};
            for (int pp = 1; pp < npart; ++pp) { const u32x2 w2 = *(const u32x2*)(delta + (size_t)pp * pstride + lane * 4 + 256 * i); d[i] = d[i] + (f32x4){bflo(w2.x), bfhi(w2.x), bflo(w2.y), bfhi(w2.y)}; }
            ss += (d[i][0] * d[i][0] + d[i][1] * d[i][1]) + (d[i][2] * d[i][2] + d[i][3] * d[i][3]); }
        const float rstd = rsqrtf(wave_sum(ss) * (1.f / DM) + EPS);
#pragma unroll
        for (int i = 0; i < 4; ++i) { const f32x4 g = *(const f32x4*)(gpost + lane * 4 + 256 * i); const f32x4 t = *(const LAS f32x4*)(gt + lane * 4 + 256 * i);
            x[i] = x[i] + t * (d[i] * rstd * g); }
    }
    if (xout) {
#pragma unroll
        for (int i = 0; i < 4; ++i) *(f32x4*)(xout + lane * 4 + 256 * i) = x[i];
    }
    if (aout) {
        float ss = 0.f;
#pragma unroll
        for (int i = 0; i < 4; ++i) ss += (x[i][0] * x[i][0] + x[i][1] * x[i][1]) + (x[i][2] * x[i][2] + x[i][3] * x[i][3]);
        const float rstd = rsqrtf(wave_sum(ss) * (1.f / DM) + EPS);
#pragma unroll
        for (int i = 0; i < 4; ++i) { const f32x4 g = *(const f32x4*)(gpre + lane * 4 + 256 * i); const f32x4 s1 = *(const LAS f32x4*)(sc + lane * 4 + 256 * i); const f32x4 s0 = *(const LAS f32x4*)(sh + lane * 4 + 256 * i);
            const f32x4 y = (x[i] * rstd * g) * (s1 + 1.f) + s0; u32x2 w; w.x = pk2(y[0], y[1]); w.y = pk2(y[2], y[3]);
            *(u32x2*)(aout + lane * 4 + 256 * i) = w; }
    }
}
__device__ __forceinline__ void phase_rows(const Params& P_, LAS unsigned char* lds, int mode, int l, int W0) {
    const Params& P = *kparams();
    const int tid = opaque_tid(W0), lane = tid & 63, wave = tid >> 6;
    LAS float* m0 = (LAS float*)lds;
    LAS float* m1 = m0 + 3072; LAS float* m2 = m1 + 3072;
    bf16_t* A = (bf16_t*)(P.ws + WS_A);
    float* hctx = (float*)(P.ws + WS_HCTX);
    if (mode == 0) { load_mod<false>(m1, P, 0, 1, tid); load_mod<false>(m2, P, 0, 0, tid);
        float* adaf = (float*)(P.ws + WS_ADAF);
        for (int i = blockIdx.x * NTHREADS + tid; i < 2 * 3 * 6144; i += gridDim.x * NTHREADS) { const int l_ = i / (3 * 6144), r_ = i % (3 * 6144); adaf[i] = ada_value(P, l_, r_ / 6144, r_ % 6144); } }
    else if (mode == 1) { load_mod<true>(m0, P, l, 2, tid); load_mod<true>(m1, P, l, 4, tid); load_mod<true>(m2, P, l, 3, tid); }
    else { load_mod<true>(m0, P, l, 5, tid); if (l + 1 < DEPTH) { load_mod<true>(m1, P, l + 1, 1, tid); load_mod<true>(m2, P, l + 1, 0, tid); } }
    __syncthreads();
    const int nrows = (mode == 0 || l == 0) ? MALL : MLAT;
    const int gw = blockIdx.x * NWAVES + wave, NGW = gridDim.x * NWAVES;
#define ROW_PTRS(row_, xin_, delta_) do { const bool lat_ = (row_) < MLAT; \
        if (mode == 0) { xin_ = lat_ ? P.in[0] + (size_t)(row_) * DM : P.in[2] + (size_t)((row_) - MLAT) * DM; delta_ = nullptr; } \
        else if (mode == 1) { xin_ = (l == 0) ? (lat_ ? P.in[0] + (size_t)(row_) * DM : P.in[2] + (size_t)((row_) - MLAT) * DM) : (P.out + (size_t)(row_) * DM); \
            delta_ = (!lat_ && l == 0) ? (const bf16_t*)(P.ws + WS_R2) + (size_t)((row_) - MLAT) * DM : (const bf16_t*)(P.ws + WS_BIG) + (size_t)(row_) * DM; } \
        else { xin_ = lat_ ? P.out + (size_t)(row_) * DM : hctx + (size_t)((row_) - MLAT) * DM; \
            delta_ = (!lat_ && l == 0) ? (const bf16_t*)(P.ws + WS_MIX) + (size_t)((row_) - MLAT) * DM : (const bf16_t*)(P.ws + WS_R2) + (size_t)(row_) * DM; } } while (0)
    RowIn cur, nxt;
    if (gw < nrows) { const float* xi; const bf16_t* de; ROW_PTRS(gw, xi, de); row_load(cur, xi, de, lane); }
    for (int row = gw; row < nrows; row += NGW) {
        const bool lat = row < MLAT; const int mid = row < NSEQ ? 0 : (lat ? 1 : 2);
        const float* xin; const bf16_t* delta; ROW_PTRS(row, xin, delta);
        if (row + NGW < nrows) { const float* xi; const bf16_t* de; ROW_PTRS(row + NGW, xi, de); row_load(nxt, xi, de, lane); }
        float* xout = nullptr; const float* gpost = nullptr; const float* gpre = nullptr; bf16_t* aout = nullptr;
        if (mode == 0) { gpre = P.in[6]; aout = A + (size_t)row * DM; }
        else if (mode == 1) { xout = lat ? P.out + (size_t)row * DM : hctx + (size_t)(row - MLAT) * DM; gpost = P.in[7] + l * DM; gpre = P.in[8] + l * DM; aout = A + (size_t)row * DM; }
        else { xout = const_cast<float*>(xin); gpost = P.in[9] + l * DM; if (l + 1 < DEPTH) { gpre = P.in[6] + (l + 1) * DM; aout = A + (size_t)row * DM; } }
        int npart = 1; const size_t pstride = (size_t)512 * DM;
        if (!lat && l == 0) { if (mode == 1) npart = 5; else if (mode == 2) npart = 11; }
        row_pass(cur, delta, npart, pstride, gpost, m0 + mid * 1024, xout, gpre, m1 + mid * 1024, m2 + mid * 1024, aout, lane);
        cur = nxt;
    }
#undef ROW_PTRS
}

template <int MAXIT>
__device__ __forceinline__ void stage_vt(LAS bf16_t* vt, int stride, int koff, const bf16_t* src0, int nkeys, int vlo, int vhi, int tid) {
    bf16x8 v0[MAXIT], v1[MAXIT];
#pragma unroll
    for (int i = 0; i < MAXIT; ++i) { const int u = tid + i * NTHREADS; const int kk = (u >> 3) * 2, dg = u & 7;
        v0[i] = (bf16x8){0, 0, 0, 0, 0, 0, 0, 0}; v1[i] = v0[i];
        if (u < nkeys * 4) { if (kk >= vlo && kk < vhi) v0[i] = *(const bf16x8*)(src0 + (ptrdiff_t)kk * DIN + dg * 8);
                             if (kk + 1 >= vlo && kk + 1 < vhi) v1[i] = *(const bf16x8*)(src0 + (ptrdiff_t)(kk + 1) * DIN + dg * 8); } }
#pragma unroll
    for (int i = 0; i < MAXIT; ++i) { const int u = tid + i * NTHREADS; const int kk = (u >> 3) * 2, dg = u & 7;
        if (u < nkeys * 4) {
#pragma unroll
            for (int e = 0; e < 8; ++e) *(LAS unsigned*)(vt + (dg * 8 + e) * stride + koff + kk) = (unsigned)(unsigned short)v0[i][e] | ((unsigned)(unsigned short)v1[i][e] << 16); } }
}

constexpr int VTS_NA = 584, VTS_SWA = 408, VTS_CTX = 264, VTS_CTXS = 296;

#define MEMBAR() asm volatile("" ::: "memory")
#define SCHEDBAR() __builtin_amdgcn_sched_barrier(0)
template <int NTILE>
__device__ __forceinline__ void softmax_pv_seg(f32x4 (&s)[NTILE], float& m, float& sum, f32x4 (&o)[4], const LAS bf16_t* vb, int vs, int ibase, int istep, int l15) {
    float mx = s[0][0];
#pragma unroll
    for (int j = 0; j < NTILE; ++j) mx = fmaxf(mx, fmaxf(fmaxf(s[j][0], s[j][1]), fmaxf(s[j][2], s[j][3])));
    mx = fmaxf(mx, __shfl_xor(mx, 16)); mx = fmaxf(mx, __shfl_xor(mx, 32));
    const float mn = fmaxf(m, mx);
    const float resc = __expf(m - mn);
    m = mn; sum *= resc;
#pragma unroll
    for (int mt = 0; mt < 4; ++mt) o[mt] = o[mt] * resc;
    float ps = 0.f;
#pragma unroll
    for (int j = 0; j < NTILE; ++j) {
#pragma unroll
        for (int e = 0; e < 4; ++e) { const float p = __expf(s[j][e] - mn); s[j][e] = p; ps += p; } }
    sum += ps;
#pragma unroll
    for (int jj = 0; jj < NTILE / 2; ++jj) {
        const f32x4 p0 = s[2 * jj], p1 = s[2 * jj + 1];
        u32x4 pw; pw.x = pk2(p0[0], p0[1]); pw.y = pk2(p0[2], p0[3]); pw.z = pk2(p1[0], p1[1]); pw.w = pk2(p1[2], p1[3]);
        const bf16x8 pf = __builtin_bit_cast(bf16x8, pw);
        const int i0x = ibase + istep * jj, i1x = i0x + 16;
#pragma unroll
        for (int mt = 0; mt < 4; ++mt) { const LAS bf16_t* vr = vb + (16 * mt + l15) * vs;
            const u32x2 v0 = *(const LAS u32x2*)(vr + i0x), v1 = *(const LAS u32x2*)(vr + i1x);
            u32x4 vw; vw.x = v0.x; vw.y = v0.y; vw.z = v1.x; vw.w = v1.y;
            o[mt] = __builtin_amdgcn_mfma_f32_16x16x32_bf16(__builtin_bit_cast(bf16x8, vw), pf, o[mt], 0, 0, 0); }
    }
}
template <int MODE>
__device__ __forceinline__ void attn_wave(const bf16_t* U, bf16_t* MIX, const LAS bf16_t* vtl, const LAS bf16_t* vtc, const LAS float* rpb,
                                          int b, int qrow  , int qcol_u, int kcol_u, int ocol, bool has_sink, float sinkv,
                                          int a0, int a1, int a2, int a3  , int lane) {
    constexpr int NT = MODE == 1 ? 18 : 16;
    constexpr int VSL = MODE == 0 ? VTS_NA : VTS_SWA, VSC = MODE == 1 ? VTS_CTXS : VTS_CTX;
    const int l15 = lane & 15, q = lane >> 4;
    const bf16_t* qp = U + (size_t)(qrow + l15) * DIN + qcol_u + 8 * q;
    const bf16x8 qf0 = *(const bf16x8*)qp, qf1 = *(const bf16x8*)(qp + 32);
    const float NEG = -__builtin_inff();
    float m = NEG, sum = 0.f;
    f32x4 o[4];
#pragma unroll
    for (int mt = 0; mt < 4; ++mt) o[mt] = (f32x4){0.f, 0.f, 0.f, 0.f};
    const int r = a0, cb = a1, rs = a2, rsA = a3;
    const int bs = min(max(16 * cb - 8, 0), 32), qc = cb * 16 + l15, cs = min(max(qc - 8, 0), 48);
    const int i0 = a0, tq = i0 + l15;
#pragma unroll 1
    for (int seg = (MODE == 2 ? 1 : 0); seg < 2; ++seg) {
        f32x4 s[NT];
#pragma unroll
        for (int j = 0; j < NT; ++j) {
            int krow;
            if (seg == 0) { if (MODE == 0) krow = b * NSEQ + (rs + (j >> 1)) * 64 + bs + 16 * (j & 1) + l15; else krow = b * NSEQ + min(max(i0 - 128 + 16 * j + l15, 0), NSEQ - 1); }
            else krow = MLAT + b * NCTX + (j < 16 ? 16 * j : 240) + l15;
            const bf16_t* kp = U + (size_t)krow * DIN + kcol_u + 8 * q;
            const bf16x8 k0 = *(const bf16x8*)kp, k1 = *(const bf16x8*)(kp + 32);
            f32x4 t = {0.f, 0.f, 0.f, 0.f};
            t = __builtin_amdgcn_mfma_f32_16x16x32_bf16(k0, qf0, t, 0, 0, 0); t = __builtin_amdgcn_mfma_f32_16x16x32_bf16(k1, qf1, t, 0, 0, 0);
#pragma unroll
            for (int e = 0; e < 4; ++e) {
                float v = t[e] * 0.125f; bool ok = (j < 16);
                if (seg == 0) {
                    if (MODE == 0) { const int kr = rs + (j >> 1), kc = bs + 16 * (j & 1) + 4 * q + e; ok = (kc >= cs) && (kc < cs + 16);
                        const int dc = min(max(kc - qc + 15, 0), 30); v += rpb[(kr - r + 7) * 31 + dc]; }
                    else if (MODE == 1) {
                        if (j >= 1 && j <= 15) { const int s0_ = i0 - 128 + 16 * j; ok = (s0_ >= 0) && (s0_ < NSEQ); }
                        else { const int sp = i0 - 128 + 16 * j + 4 * q + e; const int rel = sp - tq; ok = (rel <= 128) && (rel >= -128) && (sp >= 0) && (sp < NSEQ); } }
                }
                t[e] = ok ? v : NEG; }
            s[j] = t; if ((j & 7) == 7) __builtin_amdgcn_sched_barrier(0); }
        const LAS bf16_t* vb = seg ? vtc : vtl; const int vs = seg ? VSC : VSL;
        int ibase, istep;
        if (seg) { ibase = 4 * q; istep = 32; }
        else if (MODE == 0) { ibase = (rs - rsA) * 64 + bs + 4 * q; istep = 64; }
        else { ibase = a1 + 4 * q; istep = 32; }
        softmax_pv_seg<NT>(s, m, sum, o, vb, vs, ibase, istep, l15);
    }
    sum += __shfl_xor(sum, 16); sum += __shfl_xor(sum, 32);
    if (has_sink) { const float mn = fmaxf(m, sinkv); const float resc = __expf(m - mn); sum = sum * resc + __expf(sinkv - mn);
#pragma unroll
        for (int mt = 0; mt < 4; ++mt) o[mt] = o[mt] * resc; }
    float inv = 1.f / sum;
    if ((DBG_ZERO & 1) && (MODE == 0 || (MODE == 2 && !has_sink))) inv = 0.f;
    if ((DBG_ZERO & 2) && (MODE == 1 || (MODE == 2 && has_sink))) inv = 0.f;
    bf16_t* op = MIX + (size_t)(qrow + l15) * KOUT + ocol + 4 * q;
#pragma unroll
    for (int mt = 0; mt < 4; ++mt) { u32x2 w; w.x = pk2(o[mt][0] * inv, o[mt][1] * inv); w.y = pk2(o[mt][2] * inv, o[mt][3] * inv); *(u32x2*)(op + 16 * mt) = w; }
}

__device__ __forceinline__ void na_item(const Params& P, LAS unsigned char* lds, int l, int item, int W0) {
    const int tid = opaque_tid(W0), lane = tid & 63, wave = tid >> 6;
    const int b = item >> 8, h = (item >> 6) & 3, rp = item & 63, r0 = 2 * rp;
    const bf16_t* U = (const bf16_t*)(P.ws + WS_BIG); bf16_t* MIX = (bf16_t*)(P.ws + WS_MIX);
    LAS bf16_t* vtl = (LAS bf16_t*)lds; LAS bf16_t* vtc = vtl + 64 * VTS_NA; LAS float* rpb = (LAS float*)(vtc + 64 * VTS_CTX);
    const int rsA = min(max(r0 - 4, 0), 120); const int nrows = min(9, 128 - rsA);
    stage_vt<5>(vtl, VTS_NA, 0, U + (size_t)(b * NSEQ + rsA * 64) * DIN + C_VA + h * 64, nrows * 64, 0, nrows * 64, tid);
    stage_vt<2>(vtc, VTS_CTX, 0, U + (size_t)(MLAT + b * NCTX) * DIN + C_VA + h * 64, 256, 0, 256, tid);
    for (int i = tid; i < 15 * 31; i += NTHREADS) rpb[i] = P.in[12][(size_t)(l * 4 + h) * 465 + i];
    __syncthreads();
    const int r = r0 + (wave >> 2), cb = wave & 3; const int rs = min(max(r - 4, 0), 120);
    attn_wave<0>(U, MIX, vtl, vtc, rpb, b, b * NSEQ + r * 64 + cb * 16, C_QA + h * 64, C_KA + h * 64, O_A + h * 64, false, 0.f, r, cb, rs, rsA, lane);
    __syncthreads();
}
__device__ __forceinline__ void swa_item(const Params& P, LAS unsigned char* lds, int l, int item, int W0) {
    const int tid = opaque_tid(W0), lane = tid & 63, wave = tid >> 6;
    const int b = item >> 8, hq = (item >> 6) & 3, nb = item & 63, g = hq >> 1;
    const bf16_t* U = (const bf16_t*)(P.ws + WS_BIG); bf16_t* MIX = (bf16_t*)(P.ws + WS_MIX);
    LAS bf16_t* vtl = (LAS bf16_t*)lds; LAS bf16_t* vtc = vtl + 64 * VTS_SWA;
    const int tok0 = (nb - 1) * 128;
    stage_vt<4>(vtl, VTS_SWA, 0, U + ((ptrdiff_t)b * NSEQ + tok0) * DIN + C_VS + g * 64, 400, max(0, -tok0), min(400, NSEQ - tok0), tid);
    stage_vt<3>(vtc, VTS_CTXS, 0, U + (size_t)(MLAT + b * NCTX) * DIN + C_VS + g * 64, 288, 0, 256, tid);
    __syncthreads();
    const int i0 = nb * 128 + 16 * wave;
    attn_wave<1>(U, MIX, vtl, vtc, nullptr, b, b * NSEQ + i0, C_QS + hq * 64, C_KS + g * 64, O_C + hq * 64, true, P.in[14][l * 4 + hq], i0, 16 * wave, 0, 0, lane);
    __syncthreads();
}
__device__ __forceinline__ void ctxattn_item(const Params& P, LAS unsigned char* lds, int l, int item, int W0) {
    const int tid = opaque_tid(W0), lane = tid & 63, wave = tid >> 6;
    const bool swa = item >= 16; const int it = item & 15; const int b = it >> 3, hh = (it >> 1) & 3, half = it & 1;
    const bf16_t* U = (const bf16_t*)(P.ws + WS_BIG); bf16_t* MIX = (bf16_t*)(P.ws + WS_MIX);
    LAS bf16_t* vtc = (LAS bf16_t*)lds;
    const int vcol = swa ? C_VS + (hh >> 1) * 64 : C_VA + hh * 64;
    stage_vt<2>(vtc, VTS_CTX, 0, U + (size_t)(MLAT + b * NCTX) * DIN + vcol, 256, 0, 256, tid);
    __syncthreads();
    const int qrow = MLAT + b * NCTX + half * 128 + 16 * wave;
    if (swa) attn_wave<2>(U, MIX, nullptr, vtc, nullptr, b, qrow, C_QS + hh * 64, C_KS + (hh >> 1) * 64, O_C + hh * 64, true, P.in[14][l * 4 + hh], 0, 0, 0, 0, lane);
    else     attn_wave<2>(U, MIX, nullptr, vtc, nullptr, b, qrow, C_QA + hh * 64, C_KA + hh * 64, O_A + hh * 64, false, 0.f, 0, 0, 0, 0, lane);
    __syncthreads();
}

__device__ __forceinline__ float hgrn_lb(const Params& P, int l, int dir, int k256) {
    if (l == 0) return 0.f;
    const float l0 = P.in[15][(size_t)(dir * DEPTH + 0) * 256 + k256], l1 = P.in[15][(size_t)(dir * DEPTH + 1) * 256 + k256];
    return 1.f / (1.f + __expf(l0 - l1));
}
template <bool OUT>
__device__ __forceinline__ void hgrn_item(const Params& P, LAS unsigned char* lds, int l, int item, int W0) {
    const int tid = opaque_tid(W0), lane = tid & 63, wave = tid >> 6;
    const int b = item / NCHUNK, c = item % NCHUNK;
    const int h = wave & 3, dir = wave >> 2;
    const int row0 = c < 4 ? MLAT + b * NCTX + c * 64 : b * NSEQ + (c - 4) * 64;
    const int pos = dir == 0 ? c : (c < 4 ? 3 - c : 135 - c);
    const int chain = (b * 4 + h) * 2 + dir;
    const bf16_t* U = (const bf16_t*)(P.ws + WS_BIG);
    float* HL = (float*)(P.ws + WS_R2) + ((size_t)chain * NCHUNK + pos) * 4096;
    float* HD = (float*)(P.ws + WS_HD) + ((size_t)chain * NCHUNK + pos) * 64;
    LAS float* OB = (LAS float*)lds;
    LAS float* stg = (LAS float*)(lds + 65536) + wave * 2048;
    const float lb = hgrn_lb(P, l, dir, h * 64 + lane);
    const int fcol = (dir == 0 ? C_FF : C_FB) + h * 64 + lane;
    float S[64];
    if (OUT) {
        for (int i = tid; i < 4 * 64 * 64; i += NTHREADS) OB[i] = 0.f;
        if (c >= 4) {
#pragma unroll
            for (int j = 0; j < 64; ++j) S[j] = HL[j * 64 + lane];
        } else {
#pragma unroll
            for (int j = 0; j < 64; ++j) S[j] = 0.f;
            for (int pp = 0; pp < pos; ++pp) { const float* Lp = (const float*)(P.ws + WS_R2) + ((size_t)chain * NCHUNK + pp) * 4096; const float* Dp = (const float*)(P.ws + WS_HD) + ((size_t)chain * NCHUNK + pp) * 64;
#pragma unroll
                for (int j = 0; j < 64; ++j) S[j] = Dp[j] * S[j] + Lp[j * 64 + lane]; }
        }
        __syncthreads();
    } else {
#pragma unroll
        for (int j = 0; j < 64; ++j) S[j] = 0.f;
    }
    float D = 1.f;
    for (int sub = 0; sub < 4; ++sub) {
        float vv[16];
#pragma unroll
        for (int st = 0; st < 16; ++st) { const int step = sub * 16 + st; const int t = dir == 0 ? step : 63 - step; const bf16_t* ur = U + (size_t)(row0 + t) * DIN;
            const float fz = bf2f(ur[fcol]); const float f = lb + (1.f - lb) * sigmoidf_(fz); D *= f;
            stg[st * 128 + lane] = f;
            if (OUT) stg[st * 128 + 64 + lane] = siluf(bf2f(ur[C_QD + h * 64 + lane]));
            vv[st] = bf2f(ur[C_IV + h * 64 + lane]); }
#pragma unroll
        for (int st = 0; st < 16; ++st) { const float v = vv[st]; const LAS f32x4* fp = (const LAS f32x4*)(stg + st * 128); float oa = 0.f, ob = 0.f, oc = 0.f, od = 0.f;
#pragma unroll
            for (int j4 = 0; j4 < 16; ++j4) { if ((j4 & HG_BAR) == 0) MEMBAR(); const f32x4 f4 = fp[j4];
                S[4 * j4 + 0] = __builtin_fmaf(f4[0], S[4 * j4 + 0] - v, v); S[4 * j4 + 1] = __builtin_fmaf(f4[1], S[4 * j4 + 1] - v, v);
                S[4 * j4 + 2] = __builtin_fmaf(f4[2], S[4 * j4 + 2] - v, v); S[4 * j4 + 3] = __builtin_fmaf(f4[3], S[4 * j4 + 3] - v, v);
                if (OUT) { const f32x4 q4 = fp[16 + j4]; oa += S[4 * j4 + 0] * q4[0]; ob += S[4 * j4 + 1] * q4[1]; oc += S[4 * j4 + 2] * q4[2]; od += S[4 * j4 + 3] * q4[3]; } }
            if (OUT) { const int step = sub * 16 + st; const int t = dir == 0 ? step : 63 - step; atomicAdd((float*)(OB + (h * 64 + t) * 64 + lane), (oa + ob) + (oc + od)); } }
    }
    if (!OUT) {
#pragma unroll
        for (int j = 0; j < 64; ++j) HL[j * 64 + lane] = S[j];
        HD[lane] = D;
    } else {
        __syncthreads();
        bf16_t* MIX = (bf16_t*)(P.ws + WS_MIX);
        for (int p0 = wave; p0 < 256; p0 += 8 * NWAVES) {
            float gz[8], val[8];
#pragma unroll
            for (int i = 0; i < 8; ++i) { const int pr = p0 + i * NWAVES, hh = pr >> 6, t = pr & 63; gz[i] = bf2f(U[(size_t)(row0 + t) * DIN + C_GD + hh * 64 + lane]); val[i] = OB[(hh * 64 + t) * 64 + lane]; }
#pragma unroll
            for (int i = 0; i < 8; ++i) { const int pr = p0 + i * NWAVES, hh = pr >> 6, t = pr & 63;
                const float rstd = rsqrtf(wave_sum(val[i] * val[i]) * (1.f / 64.f) + EPS);
                const float gn = P.in[16][l * 256 + hh * 64 + lane];
                MIX[(size_t)(row0 + t) * KOUT + O_D + hh * 64 + lane] = (bf16_t)f2bf((DBG_ZERO & 4) ? 0.f : val[i] * rstd * gn * siluf(gz[i])); }
        }
        __syncthreads();
    }
}

__device__ __forceinline__ void hgrn_state_item(const Params& P, LAS unsigned char* lds, int l, int item, int W0) {
    const int tid = opaque_tid(W0), lane = tid & 63, wave = tid >> 6, l15 = lane & 15, q = lane >> 4;
    const int b = item / NCHUNK, c = item % NCHUNK;
    const int h = wave & 3, dir = wave >> 2;
    const int row0 = c < 4 ? MLAT + b * NCTX + c * 64 : b * NSEQ + (c - 4) * 64;
    const int pos = dir == 0 ? c : (c < 4 ? 3 - c : 135 - c);
    const int chain = (b * 4 + h) * 2 + dir;
    const bf16_t* U = (const bf16_t*)(P.ws + WS_BIG);
    float* HL = (float*)(P.ws + WS_R2) + ((size_t)chain * NCHUNK + pos) * 4096;
    float* HD = (float*)(P.ws + WS_HD) + ((size_t)chain * NCHUNK + pos) * 64;
    constexpr int RS = 72;
    LAS bf16_t* VT = (LAS bf16_t*)lds + h * 64 * RS;
    LAS bf16_t* KH = (LAS bf16_t*)lds + 4 * 64 * RS + wave * 64 * RS;
    const float lb = hgrn_lb(P, l, dir, h * 64 + lane);
    const int fcol = (dir == 0 ? C_FF : C_FB) + h * 64 + lane;
    float p = 1.f;
    for (int sb = 0; sb < 4; ++sb) {
        float fz[16]; unsigned short vv[16];
#pragma unroll
        for (int i = 0; i < 16; ++i) { const int step = 63 - (sb * 16 + i); const int t = dir == 0 ? step : 63 - step; const bf16_t* ur = U + (size_t)(row0 + t) * DIN;
            fz[i] = bf2f(ur[fcol]); vv[i] = (dir == 0) ? ur[C_IV + h * 64 + lane] : (unsigned short)0; }
#pragma unroll
        for (int i = 0; i < 16; i += 2) {
            const int st0 = 63 - (sb * 16 + i), st1 = st0 - 1; const int t0 = dir == 0 ? st0 : 63 - st0, t1 = dir == 0 ? st1 : 63 - st1;
            const float f0 = lb + (1.f - lb) * sigmoidf_(fz[i]); const float k0 = (1.f - f0) * p; p *= f0;
            const float f1 = lb + (1.f - lb) * sigmoidf_(fz[i + 1]); const float k1 = (1.f - f1) * p; p *= f1;
            const int te = t0 < t1 ? t0 : t1; const unsigned lo = f2bf(t0 < t1 ? k0 : k1), hi = f2bf(t0 < t1 ? k1 : k0);
            *(LAS unsigned*)(KH + lane * RS + te) = lo | (hi << 16);
            if (dir == 0) { const unsigned vlo = t0 < t1 ? vv[i] : vv[i + 1], vhi = t0 < t1 ? vv[i + 1] : vv[i]; *(LAS unsigned*)(VT + lane * RS + te) = vlo | (vhi << 16); }
        }
    }
    HD[lane] = p;
    __syncthreads();
    f32x4 acc[4][4];
#pragma unroll
    for (int mt = 0; mt < 4; ++mt)
#pragma unroll
        for (int nt = 0; nt < 4; ++nt) acc[mt][nt] = (f32x4){0.f, 0.f, 0.f, 0.f};
#pragma unroll
    for (int ks = 0; ks < 2; ++ks) {
        bf16x8 bfr[4];
#pragma unroll
        for (int nt = 0; nt < 4; ++nt) bfr[nt] = *(const LAS bf16x8*)(VT + (16 * nt + l15) * RS + 32 * ks + 8 * q);
#pragma unroll
        for (int mt = 0; mt < 4; ++mt) { const bf16x8 afr = *(const LAS bf16x8*)(KH + (16 * mt + l15) * RS + 32 * ks + 8 * q);
#pragma unroll
            for (int nt = 0; nt < 4; ++nt) acc[mt][nt] = __builtin_amdgcn_mfma_f32_16x16x32_bf16(afr, bfr[nt], acc[mt][nt], 0, 0, 0); }
    }
#pragma unroll
    for (int mt = 0; mt < 4; ++mt)
#pragma unroll
        for (int nt = 0; nt < 4; ++nt)
            *(f32x4*)(HL + ((mt * 4 + nt) * 64 + lane) * 4) = acc[mt][nt];
    __syncthreads();
}

__device__ __forceinline__ float frcp(float x) { return __builtin_amdgcn_rcpf(x); }
__device__ __forceinline__ float fsigmoid(float a) { return frcp(1.f + __expf(-a)); }
__device__ __forceinline__ float fsilu(float a) { return a * frcp(1.f + __expf(-a)); }
#define HG_LOAD_SB(SB) do { if (dir == 0) { const bf16_t* up = Ub + (size_t)((SB) * 16) * DIN; \
        _Pragma("unroll") for (int s_ = 0; s_ < 16; ++s_) { nfz[s_] = up[C_FF]; nqv[s_] = up[C_QD]; nvv[s_] = up[C_IV]; up += DIN; } } \
    else { const bf16_t* up = Ub + (size_t)(63 - (SB) * 16) * DIN; \
        _Pragma("unroll") for (int s_ = 0; s_ < 16; ++s_) { nfz[s_] = up[C_FB]; nqv[s_] = up[C_QD]; nvv[s_] = up[C_IV]; up -= DIN; } } } while (0)
__device__ __forceinline__ void hgrn_out_item(const Params& P, LAS unsigned char* lds, int l, int item, int W0) {
    const int tid = opaque_tid(W0), lane = tid & 63, wave = tid >> 6, l15 = lane & 15, q = lane >> 4;
    const int b = item / NCHUNK, c = item % NCHUNK;
    const int h = wave & 3, dir = wave >> 2;
    const int row0 = c < 4 ? MLAT + b * NCTX + c * 64 : b * NSEQ + (c - 4) * 64;
    const int pos = dir == 0 ? c : (c < 4 ? 3 - c : 135 - c);
    const int chain = (b * 4 + h) * 2 + dir;
    const bf16_t* U = (const bf16_t*)(P.ws + WS_BIG);
    const float* HLb = (const float*)(P.ws + WS_R2) + (size_t)chain * NCHUNK * 4096;
    const float* HDb = (const float*)(P.ws + WS_HD) + (size_t)chain * NCHUNK * 64;
    constexpr int OS = 66;
    LAS bf16_t* OBd = (LAS bf16_t*)lds + dir * (4 * 64 * OS);
    constexpr int QS = 68, ES = 20;
    LAS unsigned char* wb = lds + 2 * 4 * 64 * OS * 2 + wave * 9728;
    LAS bf16_t* QT = (LAS bf16_t*)wb;
    LAS bf16_t* KT = QT + 16 * QS;
    LAS bf16_t* KE = KT + 16 * QS;
    LAS bf16_t* VT = KE + 64 * ES;
    LAS float* A15 = (LAS float*)(VT + 64 * ES);
    const float lb = hgrn_lb(P, l, dir, h * 64 + lane);
    const int fcol = (dir == 0 ? C_FF : C_FB) + h * 64 + lane;
    f32x4 S[4][4];
    if (c >= 4) { const float* Hp = HLb + (size_t)pos * 4096;
#pragma unroll
        for (int mt = 0; mt < 4; ++mt)
#pragma unroll
            for (int nt = 0; nt < 4; ++nt)
                S[mt][nt] = *(const f32x4*)(Hp + ((mt * 4 + nt) * 64 + lane) * 4);
    } else {
#pragma unroll
        for (int mt = 0; mt < 4; ++mt)
#pragma unroll
            for (int nt = 0; nt < 4; ++nt) S[mt][nt] = (f32x4){0.f, 0.f, 0.f, 0.f};
        for (int pp = 0; pp < pos; ++pp) { const float* Lp = HLb + (size_t)pp * 4096; const float* Dp = HDb + pp * 64;
#pragma unroll
            for (int mt = 0; mt < 4; ++mt) { const f32x4 d4 = *(const f32x4*)(Dp + 16 * mt + 4 * q);
#pragma unroll
                for (int nt = 0; nt < 4; ++nt)
                    S[mt][nt] = d4 * S[mt][nt] + *(const f32x4*)(Lp + ((mt * 4 + nt) * 64 + lane) * 4); } }
    }
    __syncthreads();
    unsigned short nfz[16], nqv[16], nvv[16];
    const bf16_t* Ub = U + (size_t)row0 * DIN + h * 64 + lane;
    HG_LOAD_SB(0);
    for (int sb = 0; sb < 4; ++sb) {
        float fz[16], qv[16]; unsigned short vv[16];
#pragma unroll
        for (int s_ = 0; s_ < 16; ++s_) { fz[s_] = bf2f(nfz[s_]); qv[s_] = bf2f(nqv[s_]); vv[s_] = nvv[s_]; }
        if (sb < 3) HG_LOAD_SB(sb + 1);
        float a[16], kk[16]; float ap = 1.f;
#pragma unroll
        for (int s_ = 0; s_ < 16; ++s_) { const float f = lb + (1.f - lb) * fsigmoid(fz[s_]); ap *= f; a[s_] = fmaxf(ap, 1e-30f); kk[s_] = 1.f - f; }
        const float a15 = a[15];
        A15[lane] = a15;
#pragma unroll
        for (int s_ = 0; s_ < 16; s_ += 2) {
            const float ia0 = frcp(a[s_]), ia1 = frcp(a[s_ + 1]);
            const unsigned qp = pk2(fsilu(qv[s_]) * a[s_], fsilu(qv[s_ + 1]) * a[s_ + 1]), kp = pk2(kk[s_] * ia0, kk[s_ + 1] * ia1);
            QT[s_ * QS + lane] = (bf16_t)qp; QT[(s_ + 1) * QS + lane] = (bf16_t)(qp >> 16);
            KT[s_ * QS + lane] = (bf16_t)kp; KT[(s_ + 1) * QS + lane] = (bf16_t)(kp >> 16);
            *(LAS unsigned*)(KE + lane * ES + s_) = pk2(kk[s_] * a15 * ia0, kk[s_ + 1] * a15 * ia1);
            *(LAS unsigned*)(VT + lane * ES + s_) = (unsigned)vv[s_] | ((unsigned)vv[s_ + 1] << 16);
        }
        MEMBAR();
        bf16x8 qfr[2], kfr[2];
#pragma unroll
        for (int ks = 0; ks < 2; ++ks) {
            const u32x2 q0 = *(const LAS u32x2*)(QT + l15 * QS + 32 * ks + 4 * q), q1 = *(const LAS u32x2*)(QT + l15 * QS + 32 * ks + 16 + 4 * q);
            const u32x2 k0 = *(const LAS u32x2*)(KT + l15 * QS + 32 * ks + 4 * q), k1 = *(const LAS u32x2*)(KT + l15 * QS + 32 * ks + 16 + 4 * q);
            u32x4 qw; qw.x = q0.x; qw.y = q0.y; qw.z = q1.x; qw.w = q1.y; qfr[ks] = __builtin_bit_cast(bf16x8, qw);
            u32x4 kw; kw.x = k0.x; kw.y = k0.y; kw.z = k1.x; kw.w = k1.y; kfr[ks] = __builtin_bit_cast(bf16x8, kw);
        }
        f32x4 att = {0.f, 0.f, 0.f, 0.f};
        att = __builtin_amdgcn_mfma_f32_16x16x32_bf16(kfr[0], qfr[0], att, 0, 0, 0); att = __builtin_amdgcn_mfma_f32_16x16x32_bf16(kfr[1], qfr[1], att, 0, 0, 0);
#pragma unroll
        for (int e = 0; e < 4; ++e) att[e] = (4 * q + e <= l15) ? att[e] : 0.f;
        u32x4 pw; pw.x = pk2(att[0], att[1]); pw.y = pk2(att[2], att[3]); pw.z = 0u; pw.w = 0u;
        const bf16x8 pfr = __builtin_bit_cast(bf16x8, pw);
        f32x4 oT[4];
#pragma unroll
        for (int nt = 0; nt < 4; ++nt) {
            f32x4 o = {0.f, 0.f, 0.f, 0.f};
#pragma unroll
            for (int ks = 0; ks < 2; ++ks) { const f32x4 s0 = S[2 * ks][nt], s1 = S[2 * ks + 1][nt];
                u32x4 sw; sw.x = pk2(s0[0], s0[1]); sw.y = pk2(s0[2], s0[3]); sw.z = pk2(s1[0], s1[1]); sw.w = pk2(s1[2], s1[3]);
                o = __builtin_amdgcn_mfma_f32_16x16x32_bf16(__builtin_bit_cast(bf16x8, sw), qfr[ks], o, 0, 0, 0); }
            const u32x2 v0 = *(const LAS u32x2*)(VT + (16 * nt + l15) * ES + 4 * q);
            u32x4 vw; vw.x = v0.x; vw.y = v0.y; vw.z = 0u; vw.w = 0u;
            o = __builtin_amdgcn_mfma_f32_16x16x32_bf16(__builtin_bit_cast(bf16x8, vw), pfr, o, 0, 0, 0);
            oT[nt] = o;
        }
#pragma unroll
        for (int mt = 0; mt < 4; ++mt) { const f32x4 a4 = *(const LAS f32x4*)(A15 + 16 * mt + 4 * q);
            const u32x2 e0 = *(const LAS u32x2*)(KE + (16 * mt + l15) * ES + 4 * q);
            u32x4 ew; ew.x = e0.x; ew.y = e0.y; ew.z = 0u; ew.w = 0u; const bf16x8 efr = __builtin_bit_cast(bf16x8, ew);
#pragma unroll
            for (int nt = 0; nt < 4; ++nt) { const u32x2 v0 = *(const LAS u32x2*)(VT + (16 * nt + l15) * ES + 4 * q);
                u32x4 vw; vw.x = v0.x; vw.y = v0.y; vw.z = 0u; vw.w = 0u;
                S[mt][nt] = __builtin_amdgcn_mfma_f32_16x16x32_bf16(efr, __builtin_bit_cast(bf16x8, vw), S[mt][nt] * a4, 0, 0, 0); } }
        { const int step = sb * 16 + l15; const int t = dir == 0 ? step : 63 - step; LAS bf16_t* orow = OBd + (h * 64 + t) * OS + 4 * q;
#pragma unroll
          for (int nt = 0; nt < 4; ++nt) { *(LAS unsigned*)(orow + 16 * nt) = pk2(oT[nt][0], oT[nt][1]); *(LAS unsigned*)(orow + 16 * nt + 2) = pk2(oT[nt][2], oT[nt][3]); } }
        MEMBAR();
    }
    __syncthreads();
    {
        bf16_t* MIX = (bf16_t*)(P.ws + WS_MIX);
        for (int p0 = wave; p0 < 256; p0 += 8 * NWAVES) {
            float gz[8], val[8];
#pragma unroll
            for (int i = 0; i < 8; ++i) { const int pr = p0 + i * NWAVES, hh = pr >> 6, t = pr & 63; gz[i] = bf2f(U[(size_t)(row0 + t) * DIN + C_GD + hh * 64 + lane]); val[i] = bf2f(((const LAS bf16_t*)lds)[(hh * 64 + t) * OS + lane]) + bf2f(((const LAS bf16_t*)lds)[4 * 64 * OS + (hh * 64 + t) * OS + lane]); }
#pragma unroll
            for (int i = 0; i < 8; ++i) { const int pr = p0 + i * NWAVES, hh = pr >> 6, t = pr & 63;
                const float rstd = rsqrtf(wave_sum(val[i] * val[i]) * (1.f / 64.f) + EPS);
                const float gn = P.in[16][l * 256 + hh * 64 + lane];
                MIX[(size_t)(row0 + t) * KOUT + O_D + hh * 64 + lane] = (bf16_t)f2bf(val[i] * rstd * gn * fsilu(gz[i])); }
        }
    }
    __syncthreads();
}
__device__ __forceinline__ void hgrn_prefix_item(const Params& P, int item, int W0) {
    const int e = item * NTHREADS + opaque_tid(W0); const int chain = e >> 12, kv = e & 4095, k = 16 * (kv >> 10) + 4 * ((kv >> 6) & 3) + (kv & 3);
    float* HL = (float*)(P.ws + WS_R2) + (size_t)chain * NCHUNK * 4096 + kv;
    const float* HD = (const float*)(P.ws + WS_HD) + (size_t)chain * NCHUNK * 64 + k;
    float S = 0.f;
    for (int p0 = 0; p0 < NCHUNK; p0 += 12) { float tv[12], dv[12];
#pragma unroll
        for (int i = 0; i < 12; ++i) { tv[i] = HL[(size_t)(p0 + i) * 4096]; dv[i] = HD[(p0 + i) * 64]; }
#pragma unroll
        for (int i = 0; i < 12; ++i) { if (p0 + i >= 4) HL[(size_t)(p0 + i) * 4096] = S; S = dv[i] * S + tv[i]; } }
}

template <int MODE>
__device__ __forceinline__ void fnet_item(const Params& P, LAS unsigned char* lds, int item, int W0) {
    constexpr int KD = MODE == 0 ? 64 : 256, R = MODE == 0 ? 128 : (MODE == 1 ? 256 : 512), DS = KD + 8;
    const int tid = opaque_tid(W0), lane = tid & 63, wave = tid >> 6, l15 = lane & 15, q = lane >> 4;
    const bf16_t* U = (const bf16_t*)(P.ws + WS_BIG); bf16_t* MIX = (bf16_t*)(P.ws + WS_MIX); bf16_t* Y = (bf16_t*)(P.ws + WS_A);
    LAS bf16_t* DT = (LAS bf16_t*)lds;
    const bf16_t* T = (const bf16_t*)(P.ws + (MODE == 0 ? WS_TA : (MODE == 1 ? WS_TC : WS_TCTX)));
    const int b = MODE == 2 ? item : item >> (MODE == 0 ? 7 : 6);
    const int sub = MODE == 0 ? (item & 127) : (MODE == 1 ? (item & 63) : 0);
    for (int u = tid; u < KD * 16; u += NTHREADS) { const int kk = (u >> 5) * 2, cg8 = (u & 31) * 8; const bf16_t* src0; const bf16_t* src1;
        if (MODE == 0) { src0 = U + (size_t)(b * NSEQ + 128 * kk + sub) * DIN + C_UB + cg8; src1 = src0 + (size_t)128 * DIN; }
        else if (MODE == 1) { const int p = kk >> 7, t2 = kk & 127; src0 = Y + ((size_t)((b * 64 + sub) * 128 + t2) * 2 + p) * 256 + cg8; src1 = src0 + 512;
#ifdef DBG_CONSTSRC
            src0 = T + (size_t)kk * 256 + cg8; src1 = src0 + 256;
#endif
        }
        else { src0 = U + (size_t)(MLAT + b * NCTX + kk) * DIN + C_UB + cg8; src1 = src0 + DIN; }
        const bf16x8 v0 = *(const bf16x8*)src0, v1 = *(const bf16x8*)src1;
#pragma unroll
        for (int e = 0; e < 8; ++e) *(LAS unsigned*)(DT + (cg8 + e) * DS + kk) = (unsigned)(unsigned short)v0[e] | ((unsigned)(unsigned short)v1[e] << 16); }
    __syncthreads();
    bf16x8 df[2][KD / 32];
#pragma unroll
    for (int ct = 0; ct < 2; ++ct)
#pragma unroll
        for (int ks = 0; ks < KD / 32; ++ks) df[ct][ks] = *(const LAS bf16x8*)(DT + ((2 * wave + ct) * 16 + l15) * DS + 32 * ks + 8 * q);
    for (int rt = 0; rt < R / 32; ++rt) {
        f32x4 acc[2][2];
#pragma unroll
        for (int ct = 0; ct < 2; ++ct)
#pragma unroll
            for (int p = 0; p < 2; ++p) acc[ct][p] = (f32x4){0.f, 0.f, 0.f, 0.f};
#pragma unroll
        for (int ks = 0; ks < KD / 32; ++ks) {
            const bf16x8 t0 = *(const bf16x8*)(T + (size_t)(16 * rt + l15) * KD + 32 * ks + 8 * q);
            const bf16x8 t1 = *(const bf16x8*)(T + (size_t)(R / 2 + 16 * rt + l15) * KD + 32 * ks + 8 * q);
#pragma unroll
            for (int ct = 0; ct < 2; ++ct) { acc[ct][0] = __builtin_amdgcn_mfma_f32_16x16x32_bf16(df[ct][ks], t0, acc[ct][0], 0, 0, 0);
                                             acc[ct][1] = __builtin_amdgcn_mfma_f32_16x16x32_bf16(df[ct][ks], t1, acc[ct][1], 0, 0, 0); }
        }
        const int rr = 16 * rt + l15;
        float tc = 1.f, tsn = 0.f;
        if (MODE == 0) sincospif((float)(rr * sub) * (1.f / 4096.f), &tsn, &tc);
#pragma unroll
        for (int ct = 0; ct < 2; ++ct) { const int ch = (2 * wave + ct) * 16 + 4 * q; f32x4 re = acc[ct][0], im = acc[ct][1];
            if (MODE == 0) { const f32x4 r2 = re * tc + im * tsn, i2 = im * tc - re * tsn; re = r2; im = i2; }
            if ((DBG_ZERO & 8) && MODE != 0) { re = re * 0.f; im = im * 0.f; }
            if ((DBG_ZERO & 64) && MODE != 0) { im = im * 0.f; }
            if ((DBG_ZERO & 128) && MODE != 0) { re = re * 0.f; }
            u32x2 wr_, wi_; wr_.x = pk2(re[0], re[1]); wr_.y = pk2(re[2], re[3]); wi_.x = pk2(im[0], im[1]); wi_.y = pk2(im[2], im[3]);
            if (MODE == 0) { bf16_t* yp = Y + ((size_t)((b * 64 + rr) * 128 + sub) * 2) * 256 + ch; *(u32x2*)yp = wr_; *(u32x2*)(yp + 256) = wi_; }
            else { const size_t row = MODE == 1 ? (size_t)(b * NSEQ + sub + 64 * rr) : (size_t)(MLAT + b * NCTX + rr); bf16_t* mp = MIX + row * KOUT + O_Z + ch; *(u32x2*)mp = wr_; *(u32x2*)(mp + 256) = wi_; }
        }
    }
    __syncthreads();
}


__device__ __forceinline__ void phase_m1(const Params& P_, LAS unsigned char* lds, int l, int W0) {
    const Params& P = *kparams();
    const int bid = blockIdx.x;
    for (int k = 0; k < 3; ++k) {
        int type = -1, id = 0;
        if (k == 0) { type = 0; id = (bid >> 7) * NCHUNK + 4 + (bid & 127); }
        else if (k == 1) { if (bid < 8) { type = 0; id = (bid >> 2) * NCHUNK + (bid & 3); } else { type = 1; id = bid - 8; } }
        else { if (bid >= 8 && bid < 16) { type = 1; id = 248 + (bid - 8); } else if (l == 0 && (bid == 16 || bid == 17)) { type = 2; id = bid - 16; } }
        if (type == 0) hgrn_state_item(P, lds, l, id, W0); else if (type == 1) fnet_item<0>(P, lds, id, W0); else if (type == 2) fnet_item<2>(P, lds, id, W0);
    }
    na_item(P, lds, l, bid, W0);
}
__device__ __forceinline__ void phase_m2(const Params& P_, LAS unsigned char* lds, int l, int rep, int W0) {
    const Params& P = *kparams();
    const int bid = blockIdx.x;
    const int NW = (l == 0) ? 248 : 256, wb = (l == 0) ? bid - 8 : bid, NIT = 128 + 128 + 256 + 256 + ((l == 0) ? 32 : 0);
    if (wb < 0) { hgrn_out_item(P, lds, l, (bid >> 2) * NCHUNK + (bid & 3), W0); return; }
    for (int it = wb; it < NIT; it += NW) {
        if (it < 128) fnet_item<1>(P, lds, it, W0);
        else if (it < 256) { if (rep == 0) hgrn_prefix_item(P, it - 128, W0); }
        else if (it < 512) na_item(P, lds, l, 256 + (it - 256), W0);
        else if (it < 768) swa_item(P, lds, l, it - 512, W0);
        else ctxattn_item(P, lds, l, it - 768, W0);
    }
}
__device__ __forceinline__ void phase_m3(const Params& P_, LAS unsigned char* lds, int l, int W0) {
    const Params& P = *kparams();
    const int bid = blockIdx.x;
    for (int rep = 0; rep < ((DBG_DUP2 & 1) ? 2 : 1); ++rep) hgrn_out_item(P, lds, l, (bid >> 7) * NCHUNK + 4 + (bid & 127), W0);
    for (int rep = 0; rep < ((DBG_DUP2 & 2) ? 2 : 1); ++rep) swa_item(P, lds, l, 256 + bid, W0);
}

template <class Epi>
__device__ __forceinline__ void run_gemm(LAS unsigned char* lds, const bf16_t* A, const bf16_t* Bt, int M, int N, int K, const Epi& E, int W0) {
    pg8::Gemm g{A, Bt, M, N, K, K}; pg8::StaticOrder S; S.init(M, N, (int)gridDim.x, (int)blockIdx.x);
    pg8::gemm_phase<Epi, pg8::StaticOrder, true, true>((PG8_LAS unsigned char*)lds, g, S, E, W0);
    __syncthreads();
}
template <class Epi>
__device__ __forceinline__ void run_gemm_split(LAS unsigned char* lds, const bf16_t* A, const bf16_t* Bt, int M, int N, int K, int NS, const Epi& E, int W0) {
    pg8::Gemm g{A, Bt, M, N, K / NS, K}; pg8::SplitOrder S; S.init(M, N, NS, (int)gridDim.x, (int)blockIdx.x);
    pg8::gemm_phase<Epi, pg8::SplitOrder, true, true>((PG8_LAS unsigned char*)lds, g, S, E, W0);
    __syncthreads();
}

#define GAS __attribute__((address_space(1)))
#define XB_TMO      128
#define XB_XCNT(j)  (256  + 64 * (j))
#define XB_XSUB(j)  (1280 + 64 * (j))
#define XB_XGEN(j)  (2304 + 64 * (j))
#define XB_TOP      3328
#define XB_TOPGEN   3392
#define XCD_BAR_WORDS 3456
#define XB_SPIN_CAP (1u << 18)

__device__ __forceinline__ unsigned xb_ld(unsigned* p)              { return __hip_atomic_load(p, __ATOMIC_RELAXED, __HIP_MEMORY_SCOPE_AGENT); }
__device__ __forceinline__ unsigned xb_add(unsigned* p, unsigned v) { return __hip_atomic_fetch_add(p, v, __ATOMIC_RELAXED, __HIP_MEMORY_SCOPE_AGENT); }
__device__ __forceinline__ unsigned xb_xcc_id() { return (unsigned)__builtin_amdgcn_s_getreg((3 << 11) | 20) & 0xFu; }
#define XB_SPIN(cond, bar) do { unsigned _sp = 0; while (cond) { __builtin_amdgcn_s_sleep(1); \
    if ((++_sp & 255u) == 0u) { if (xb_ld(&(bar)[XB_TMO])) break; if (_sp > XB_SPIN_CAP) { atomicAdd(&(bar)[XB_TMO], 1u); break; } } } } while (0)

struct XcdBarrier {
    unsigned* bar; unsigned x;
    volatile LAS unsigned* st;
};

__device__ __forceinline__ XcdBarrier xcd_barrier_post(unsigned* bar, volatile LAS unsigned* st) {
    XcdBarrier b; b.bar = bar; b.x = xb_xcc_id(); b.st = st;
    if (threadIdx.x == 0) (void)xb_add(&bar[XB_XCNT(b.x)], 1u);
    return b;
}
__device__ __forceinline__ void xcd_barrier_complete(unsigned* bar, unsigned x, unsigned& nloc, unsigned& nx) {
    const unsigned G = gridDim.x * gridDim.y * gridDim.z;
    unsigned sum, cnt, mine, sp = 0u;
    for (;;) {
        sum = 0u; cnt = 0u; mine = 0u;
#pragma unroll
        for (unsigned j = 0; j < 16; ++j) { const unsigned c = xb_ld(&bar[XB_XCNT(j)]); sum += c; cnt += (c > 0u) ? 1u : 0u; mine = (j == x) ? c : mine; }
        if (sum == G) break;
        __builtin_amdgcn_s_sleep(1);
        if ((++sp & 255u) == 0u) { if (xb_ld(&bar[XB_TMO])) break; if (sp > XB_SPIN_CAP) { atomicAdd(&bar[XB_TMO], 1u); break; } }
    }
    nloc = mine > 0u ? mine : 1u; nx = cnt > 0u ? cnt : 1u;
}

__device__ __forceinline__ void xcd_barrier(const XcdBarrier& b) {
    asm volatile("s_waitcnt vmcnt(0)" ::: "memory");
    __syncthreads();
    if (threadIdx.x == 0) {
        unsigned* bar = b.bar;
        __builtin_amdgcn_s_waitcnt(0);
        unsigned nloc = b.st[0], nx = b.st[1];
        if (nloc == 0u) { xcd_barrier_complete(bar, b.x, nloc, nx); b.st[0] = nloc; b.st[1] = nx; }
        const unsigned old = xb_add(&bar[XB_XSUB(b.x)], 1u);
        const unsigned gen = old / nloc;
        if (old + 1u == (gen + 1u) * nloc) {
            __builtin_amdgcn_fence(__ATOMIC_RELEASE, "agent");
            asm volatile("s_waitcnt vmcnt(0)" ::: "memory");
            const unsigned og = xb_add(&bar[XB_TOP], 1u);
            const unsigned tg = og / nx;
            if (og + 1u == (tg + 1u) * nx) xb_add(&bar[XB_TOPGEN], 1u);
            else XB_SPIN(xb_ld(&bar[XB_TOPGEN]) == tg, bar);
            __builtin_amdgcn_fence(__ATOMIC_ACQUIRE, "agent");
            xb_add(&bar[XB_XGEN(b.x)], 1u);
            asm volatile("s_waitcnt vmcnt(0)" ::: "memory");
        } else {
            XB_SPIN(xb_ld(&bar[XB_XGEN(b.x)]) == gen, bar);
            __builtin_amdgcn_fence(__ATOMIC_ACQUIRE, "agent");
            asm volatile("s_waitcnt vmcnt(0)" ::: "memory");
        }
    }
    __syncthreads();
}

constexpr int NPHASES = 2 + 9 * DEPTH;
#define GRID_SYNC() xcd_barrier(bar)
template <int L>
__device__ __forceinline__ void layer_phases(LAS unsigned char* lds, const int W0, const XcdBarrier& bar) {
    constexpr int Mrows = (L == 0) ? MALL : MLAT;
    { const Params& P = *kparams(); unsigned char* ws = P.ws; const unsigned char* wl = ws + WS_W + (size_t)L * SZ_WL;
      EpiU E{(bf16_t*)(ws + WS_BIG), (const float*)(ws + WS_ROPE)}; run_gemm(lds, (const bf16_t*)(ws + WS_A), (const bf16_t*)wl, MALL, DIN, DM, E, W0); }
    GRID_SYNC();
    { const Params& P = *kparams(); phase_m1(P, lds, L, W0); }
#if DBG_DUPK & 2
    GRID_SYNC(); { const Params& P = *kparams(); phase_m1(P, lds, L, W0); }
#endif
    GRID_SYNC();
    { const Params& P = *kparams(); phase_m2(P, lds, L, 0, W0); }
#if DBG_DUPK & 4
    GRID_SYNC(); { const Params& P = *kparams(); phase_m2(P, lds, L, 1, W0); }
#endif
    GRID_SYNC();
    { const Params& P = *kparams(); phase_m3(P, lds, L, W0); }
#if DBG_DUPK & 8
    GRID_SYNC(); { const Params& P = *kparams(); phase_m3(P, lds, L, W0); }
#endif
    GRID_SYNC();
    { const Params& P = *kparams(); unsigned char* ws = P.ws; const unsigned char* wl = ws + WS_W + (size_t)L * SZ_WL;
      EpiPlain E{(bf16_t*)(ws + WS_BIG), DM, 0}; run_gemm(lds, (const bf16_t*)(ws + WS_MIX), (const bf16_t*)(wl + SZ_WIN), MLAT, DM, KOUT, E, W0);
      if (L == 0) { EpiPlain E2{(bf16_t*)(ws + WS_R2), DM, (size_t)512 * DM}; run_gemm_split(lds, (const bf16_t*)(ws + WS_MIX) + (size_t)MLAT * KOUT, (const bf16_t*)(wl + SZ_WIN), 512, DM, KOUT, 5, E2, W0); } }
    GRID_SYNC();
    { const Params& P = *kparams(); phase_rows(P, lds, 1, L, W0); }
    GRID_SYNC();
    { const Params& P = *kparams(); unsigned char* ws = P.ws; const unsigned char* wl = ws + WS_W + (size_t)L * SZ_WL;
      EpiSwiGLU E{(bf16_t*)(ws + WS_BIG), DFF}; run_gemm(lds, (const bf16_t*)(ws + WS_A), (const bf16_t*)(wl + SZ_WIN + SZ_WOUT), Mrows, 2 * DFF, DM, E, W0); }
    GRID_SYNC();
    { const Params& P = *kparams(); unsigned char* ws = P.ws; const unsigned char* wl = ws + WS_W + (size_t)L * SZ_WL;
      EpiPlain E{(bf16_t*)(ws + WS_R2), DM, 0}; run_gemm(lds, (const bf16_t*)(ws + WS_BIG), (const bf16_t*)(wl + SZ_WIN + SZ_WOUT + SZ_WFI), MLAT, DM, DFF, E, W0);
      if (L == 0) { EpiPlain E2{(bf16_t*)(ws + WS_MIX), DM, (size_t)512 * DM}; run_gemm_split(lds, (const bf16_t*)(ws + WS_BIG) + (size_t)MLAT * DFF, (const bf16_t*)(wl + SZ_WIN + SZ_WOUT + SZ_WFI), 512, DM, DFF, 11, E2, W0); } }
    GRID_SYNC();
    { const Params& P = *kparams(); phase_rows(P, lds, 2, L, W0); }
}

__global__ void __launch_bounds__(NTHREADS, 2) mega_fwd(Params P) {
    extern __shared__ __attribute__((aligned(16))) unsigned char smem[];
    LAS unsigned char* lds = (LAS unsigned char*)smem;
    const int W0 = __builtin_amdgcn_readfirstlane((int)threadIdx.x >> 6);
    volatile LAS unsigned* st = (volatile LAS unsigned*)(lds + LDS_BYTES - 64);
    if (threadIdx.x == 0) { st[0] = 0u; st[1] = 0u; }
    __syncthreads();
    const XcdBarrier bar = xcd_barrier_post((unsigned*)(P.ws + WS_CTL), st);
    phase0(P, lds, W0);
#if DBG_DUPK & 1
    GRID_SYNC(); phase0(P, lds, W0);
#endif
    __syncthreads(); cg::this_grid().sync();
    phase_rows(P, lds, 0, 0, W0);
#if DBG_DUPK & 16
    GRID_SYNC(); phase_rows(P, lds, 0, 0, W0);
#endif
    GRID_SYNC();
    layer_phases<0>(lds, W0, bar);
    GRID_SYNC();
    layer_phases<1>(lds, W0, bar);
}

#if DBG_NAIVE & 2
__global__ void __launch_bounds__(64) dbg_hgrn_naive(Params P, int l, int dir) {
    const int lane = threadIdx.x, b = blockIdx.x >> 2, h = blockIdx.x & 3;
    const bf16_t* U = (const bf16_t*)(P.ws + WS_BIG); bf16_t* MIX = (bf16_t*)(P.ws + WS_MIX);
    float* OF = (float*)(P.ws + WS_A + 16777216);
    const float lb = hgrn_lb(P, l, dir, h * 64 + lane);
    const int fcol = (dir == 0 ? C_FF : C_FB) + h * 64 + lane;
    float S[64];
#pragma unroll
    for (int j = 0; j < 64; ++j) S[j] = 0.f;
    for (int step = 0; step < NCTX + NSEQ; ++step) {
        int row; if (step < NCTX) row = MLAT + b * NCTX + (dir == 0 ? step : NCTX - 1 - step); else { const int s2 = step - NCTX; row = b * NSEQ + (dir == 0 ? s2 : NSEQ - 1 - s2); }
        const bf16_t* ur = U + (size_t)row * DIN;
        const float f = lb + (1.f - lb) * sigmoidf_(bf2f(ur[fcol])); const float q = siluf(bf2f(ur[C_QD + h * 64 + lane])); const float v = bf2f(ur[C_IV + h * 64 + lane]);
        float o = 0.f;
#pragma unroll
        for (int j = 0; j < 64; ++j) { const float fj = __shfl(f, j), qj = __shfl(q, j); S[j] = fj * (S[j] - v) + v; o += S[j] * qj; }
        float* op = OF + (size_t)row * 256 + h * 64 + lane;
        if (dir == 0) *op = o;
        else { const float val = *op + o; const float rstd = rsqrtf(wave_sum(val * val) * (1.f / 64.f) + EPS);
            const float gn = P.in[16][l * 256 + h * 64 + lane]; const float gz = bf2f(ur[C_GD + h * 64 + lane]);
            MIX[(size_t)row * KOUT + O_D + h * 64 + lane] = (bf16_t)f2bf(val * rstd * gn * siluf(gz)); }
    }
}
#endif

#if DBG_NAIVE & 56
__global__ void __launch_bounds__(256) dbg_gemm(const bf16_t* A, int K, const float* W, int ldw, int N, int emode, bf16_t* O, int ldo) {
    const int n = blockIdx.x * 256 + threadIdx.x, row0 = blockIdx.y * 16;
    float acc[16], acc2[16];
#pragma unroll
    for (int r = 0; r < 16; ++r) { acc[r] = 0.f; acc2[r] = 0.f; }
    for (int k8 = 0; k8 < K; k8 += 8) {
        float w[8], w2[8];
#pragma unroll
        for (int i = 0; i < 8; ++i) { w[i] = W[(size_t)(k8 + i) * ldw + n]; w2[i] = emode == 1 ? W[(size_t)(k8 + i) * ldw + N + n] : 0.f; }
#pragma unroll
        for (int r = 0; r < 16; ++r) { const bf16x8 a = *(const bf16x8*)(A + (size_t)(row0 + r) * K + k8);
#pragma unroll
            for (int i = 0; i < 8; ++i) { const float av = bf2f((unsigned short)a[i]); acc[r] += av * w[i]; if (emode == 1) acc2[r] += av * w2[i]; } }
    }
#pragma unroll
    for (int r = 0; r < 16; ++r) { const float v = emode == 1 ? siluf(acc[r]) * acc2[r] : acc[r]; O[(size_t)(row0 + r) * ldo + n] = (bf16_t)f2bf(v); }
}
#endif

#if DBG_NAIVE & 32
__global__ void dbg_fcs(const bf16_t* MIX, bf16_t* F, int M) {
    const int row = blockIdx.x, gm = threadIdx.x, g = gm >> 6, m = gm & 63; if (row >= M) return;
    float s = 0.f;
    for (int j = 0; j < 64; ++j) { float sn, cs; sincospif((float)((m * j) & 63) * (1.f / 32.f), &sn, &cs);
        s += bf2f(MIX[(size_t)row * KOUT + O_Z + g * 64 + j]) * cs + bf2f(MIX[(size_t)row * KOUT + O_Z + 256 + g * 64 + j]) * sn; }
    F[(size_t)row * 256 + gm] = (bf16_t)f2bf(s * 0.125f);
}
__global__ void dbg_cc(const bf16_t* MIX, bf16_t* CC, int M) {
    const int row = blockIdx.x, c = threadIdx.x; if (row >= M) return;
    CC[(size_t)row * 1024 + c] = MIX[(size_t)row * KOUT + O_A + c]; CC[(size_t)row * 1024 + 512 + c] = MIX[(size_t)row * KOUT + O_C + c]; CC[(size_t)row * 1024 + 768 + c] = MIX[(size_t)row * KOUT + O_D + c];
}
#endif
#ifdef DBG_STOP
__global__ void dbg_dump(float* out, const unsigned short* ws16, int n) {
    for (int i = blockIdx.x * blockDim.x + threadIdx.x; i < n; i += gridDim.x * blockDim.x) {
        const unsigned ob = __builtin_bit_cast(unsigned, out[i]); float s = (float)(ob >> 16) + (float)(ob & 0xffffu);
        for (int c = 0; c < 8; ++c) { const size_t idx = (size_t)i + (size_t)c * n; if (idx < WS_END / 2) s += (float)ws16[idx]; }
        out[i] = s; }
}
#endif
extern "C" void kernel_launch(void* const* d_in, const int* in_sizes, int n_in, void* d_out, int out_size, void* d_ws, size_t ws_size, hipStream_t stream) {
    static int grid = 0;
    if (grid == 0) {
        if (n_in != 19 || ws_size < WS_END) { fprintf(stderr, "kernel_launch: unexpected inputs (n_in %d, ws %zu, need %zu)\n", n_in, ws_size, (size_t)WS_END); grid = -1; return; }
        if (hipFuncSetAttribute((const void*)mega_fwd, hipFuncAttributeMaxDynamicSharedMemorySize, LDS_BYTES) != hipSuccess) { fprintf(stderr, "kernel_launch: hipFuncSetAttribute failed\n"); grid = -1; return; }
        int dev = 0, cus = 0, per_cu = 0;
        hipGetDevice(&dev); hipDeviceGetAttribute(&cus, hipDeviceAttributeMultiprocessorCount, dev);
        hipOccupancyMaxActiveBlocksPerMultiprocessor(&per_cu, (const void*)mega_fwd, NTHREADS, LDS_BYTES);
        if (per_cu < 1) { fprintf(stderr, "kernel_launch: occupancy query says %d blocks per CU\n", per_cu); per_cu = 1; }
        (void)hipGetLastError();
        grid = cus * per_cu;
        if (grid != 256) { fprintf(stderr, "kernel_launch: this kernel's phase programs are dealt for exactly 256 co-resident workgroups (256 CUs x 1); got %d; nothing launched\n", grid); grid = -1; return; }
    }
    if (grid < 0) return;
#ifdef DBG_MEMSET
    (void)hipMemsetAsync(d_ws, 0, WS_END, stream);
#endif
    if (hipMemsetAsync((char*)d_ws + WS_CTL, 0, CTL_BYTES, stream) != hipSuccess) { fprintf(stderr, "kernel_launch: memset of barrier words failed\n"); return; }
    Params p{};
    for (int i = 0; i < 19; ++i) p.in[i] = (const float*)d_in[i];
    p.out = (float*)d_out; p.ws = (unsigned char*)d_ws;
    p.ph_lo = 0; p.ph_hi = NPHASES;
    void* args[] = {&p};
    hipError_t e = hipLaunchCooperativeKernel((const void*)mega_fwd, dim3(grid), dim3(NTHREADS), args, LDS_BYTES, stream);
    if (e != hipSuccess) fprintf(stderr, "cooperative launch failed: %s (grid %d)\n", hipGetErrorString(e), grid);
}
```
